# Optimizing an MI355X kernel written in HIP

```python
import math
import jax, jax.numpy as jnp
from jax import lax
import numpy as np

D_MODEL = 1024
BATCH = 32
SEQ = 2048
DEPTH = 2
DEC_BATCH = 8
DEC_SEQ = 8192
PAST_LEN = 128

GRID_W = 64
EPS = 1e-6
MIX_WIDTH = D_MODEL
FOUR_GROUPS = 4
FOUR_DIM = 64
FOUR_WIDTH = FOUR_GROUPS * FOUR_DIM
DN_HEADS = 4
DN_HEAD_DIM = 64
DN_WIDTH = DN_HEADS * DN_HEAD_DIM
DN_CHUNK = 64
CONV_W = 3
N_HEADS = 8
N_KV_HEADS = 2
HEAD_DIM = 64
GROUP = N_HEADS // N_KV_HEADS
ATTN_WIDTH = N_HEADS * HEAD_DIM
KV_WIDTH = N_KV_HEADS * HEAD_DIM
Q_BLOCK = 128
ROPE_THETA = 10000.0
AXIS_DIM = HEAD_DIM // 2
ROPE_FREQS = AXIS_DIM // 2
MEM_TOKENS = 256
MEM_HEADS = 4
MEM_HEAD_DIM = D_MODEL // MEM_HEADS
D_FF = 2816
IN_SPLITS = (FOUR_WIDTH, 3 * DN_WIDTH, 2 * DN_HEADS, 2 * DN_HEADS, DN_WIDTH, ATTN_WIDTH, KV_WIDTH, KV_WIDTH)
IN_WIDTH = FOUR_WIDTH + 4 * DN_WIDTH + 4 * DN_HEADS + ATTN_WIDTH + 2 * KV_WIDTH

kernel_name = 'hybrid_fourier_deltanet_gqa_encoder'


def rmsnorm(x, w):
    xf = x.astype(jnp.float32)
    y = xf * lax.rsqrt(jnp.mean(xf * xf, axis=-1, keepdims=True) + EPS)
    return (y * w.astype(jnp.float32)).astype(x.dtype)


def l2norm(x):
    return x * lax.rsqrt(jnp.sum(x * x, axis=-1, keepdims=True) + EPS)


def split_cols(z, sizes):
    out, start = [], 0
    for s in sizes:
        out.append(z[..., start:start + s])
        start += s
    return out


def swiglu(x, w_gu, w_down):
    g, u = jnp.split(x @ w_gu, 2, axis=-1)
    return (jax.nn.silu(g) * u) @ w_down


def fourier_mix(u, w_four):
    B, S, _ = u.shape
    ug = u.reshape(B, S, FOUR_GROUPS, FOUR_DIM).astype(jnp.float32)
    f = jnp.fft.fft2(ug, axes=(1, 3), norm='ortho').real
    y = jnp.einsum('bsgc,gcd->bsgd', f.astype(u.dtype), w_four)
    return y.reshape(B, S, FOUR_WIDTH)


def short_conv(z, w):
    pad = CONV_W // 2
    S = z.shape[1]
    zp = jnp.pad(z, ((0, 0), (pad, pad), (0, 0)))
    out = zp[:, 0:S] * w[0]
    for i in range(1, CONV_W):
        out = out + zp[:, i:i + S] * w[i]
    return jax.nn.silu(out)


def gated_delta_chunked(q, k, v, g, beta):
    B, S, H, D = q.shape
    C = DN_CHUNK
    N = S // C

    def to_chunks(t):
        t = t.reshape((B, N, C, H) + t.shape[3:])
        return jnp.moveaxis(t, 3, 1)

    q, k, v = to_chunks(q), to_chunks(k), to_chunks(v)
    g, beta = to_chunks(g), to_chunks(beta)
    gc = jnp.cumsum(g, axis=-1)
    causal = jnp.tril(jnp.ones((C, C), dtype=bool))
    strict = jnp.tril(jnp.ones((C, C), dtype=bool), -1)
    decay = jnp.exp(jnp.where(causal, gc[..., :, None] - gc[..., None, :], -jnp.inf))
    k_beta = k * beta[..., None]
    kk = jnp.einsum('bhnid,bhnjd->bhnij', k_beta, k)
    A = jnp.where(strict, kk * decay, 0.0) + jnp.eye(C, dtype=q.dtype)
    rhs = jnp.concatenate([v * beta[..., None], k_beta * jnp.exp(gc)[..., None]], axis=-1)
    sol = lax.linalg.triangular_solve(A, rhs, left_side=True, lower=True, unit_diagonal=True)
    u_val, w_key = sol[..., :D], sol[..., D:]
    qk = jnp.where(causal, jnp.einsum('bhnid,bhnjd->bhnij', q, k) * decay, 0.0)
    g_last = gc[..., -1]
    k_tail = k * jnp.exp(g_last[..., None] - gc)[..., None]
    q_dec = q * jnp.exp(gc)[..., None]

    def step(state, xs):
        qd, qkc, uc, wc, kt, gl = xs
        v_new = uc - jnp.einsum('bhcd,bhde->bhce', wc, state)
        o = jnp.einsum('bhcd,bhde->bhce', qd, state) + jnp.einsum('bhij,bhje->bhie', qkc, v_new)
        state = state * jnp.exp(gl)[..., None, None] + jnp.einsum('bhcd,bhce->bhde', kt, v_new)
        return state, o

    xs = tuple(jnp.moveaxis(t, 2, 0) for t in (q_dec, qk, u_val, w_key, k_tail, g_last))
    state0 = jnp.zeros((B, H, D, D), q.dtype)
    _, o = lax.scan(step, state0, xs)
    o = jnp.moveaxis(o, 0, 2)
    return jnp.moveaxis(o, 1, 3).reshape(B, S, H, D)


def deltanet_mix(qkv, a, b, gate, conv_w, A_log, dt_bias, out_norm):
    B, S, _ = qkv.shape
    dt = qkv.dtype
    f32 = jnp.float32
    qkv = short_conv(qkv, conv_w).astype(f32)
    q, k, v = jnp.split(qkv, 3, axis=-1)
    q = l2norm(q.reshape(B, S, DN_HEADS, DN_HEAD_DIM)) * (DN_HEAD_DIM ** -0.5)
    k = l2norm(k.reshape(B, S, DN_HEADS, DN_HEAD_DIM))
    v = v.reshape(B, S, DN_HEADS, DN_HEAD_DIM)
    a = a.astype(f32).reshape(B, S, 2, DN_HEADS)
    b = b.astype(f32).reshape(B, S, 2, DN_HEADS)
    g = -jnp.exp(A_log.astype(f32)) * jax.nn.softplus(a + dt_bias.astype(f32))
    beta = jax.nn.sigmoid(b)
    o_f = gated_delta_chunked(q, k, v, g[:, :, 0], beta[:, :, 0])
    flip = lambda t: jnp.flip(t, axis=1)
    o_b = flip(gated_delta_chunked(flip(q), flip(k), flip(v), flip(g[:, :, 1]), flip(beta[:, :, 1])))
    o = rmsnorm(o_f + o_b, out_norm) * jax.nn.silu(gate.astype(f32).reshape(B, S, DN_HEADS, DN_HEAD_DIM))
    return o.reshape(B, S, DN_WIDTH).astype(dt)


def axial_rope(n_tokens):
    rows = n_tokens // GRID_W
    row = jnp.repeat(jnp.arange(rows), GRID_W).astype(jnp.float32)
    col = jnp.tile(jnp.arange(GRID_W), rows).astype(jnp.float32)
    inv = 1.0 / (ROPE_THETA ** (jnp.arange(ROPE_FREQS, dtype=jnp.float32) * (2.0 / AXIS_DIM)))
    ang = jnp.stack([row[:, None] * inv, col[:, None] * inv], axis=1)
    return jnp.cos(ang), jnp.sin(ang)


def apply_rope(x, cos, sin):
    B, S, H, _ = x.shape
    xf = x.astype(jnp.float32).reshape(B, S, H, 2, 2, ROPE_FREQS)
    x1, x2 = xf[..., 0, :], xf[..., 1, :]
    c, s = cos[:, None], sin[:, None]
    out = jnp.stack([x1 * c - x2 * s, x2 * c + x1 * s], axis=-2)
    return out.reshape(B, S, H, HEAD_DIM).astype(x.dtype)


def gqa_attention(q, k, v, q_norm, k_norm, cos, sin):
    B, S, _ = q.shape
    q = apply_rope(rmsnorm(q.reshape(B, S, N_HEADS, HEAD_DIM), q_norm), cos, sin)
    k = apply_rope(rmsnorm(k.reshape(B, S, N_KV_HEADS, HEAD_DIM), k_norm), cos, sin)
    v = v.reshape(B, S, N_KV_HEADS, HEAD_DIM)
    nb = S // Q_BLOCK
    qb = jnp.moveaxis(q.reshape(B, nb, Q_BLOCK, N_KV_HEADS, GROUP, HEAD_DIM), 1, 0)
    scale = HEAD_DIM ** -0.5

    def block(qi):
        s = jnp.einsum('bqkgd,bskd->bkgqs', qi, k).astype(jnp.float32) * scale
        p = jax.nn.softmax(s, axis=-1)
        return jnp.einsum('bkgqs,bskd->bqkgd', p.astype(v.dtype), v)

    o = lax.map(block, qb)
    return jnp.moveaxis(o, 0, 1).reshape(B, S, ATTN_WIDTH)


def memory_cross_attention(h, mem, wq, wkv, wo):
    B, S, _ = h.shape
    M = mem.shape[1]
    q = (h @ wq).reshape(B, S, MEM_HEADS, MEM_HEAD_DIM)
    k, v = jnp.split(mem @ wkv, 2, axis=-1)
    k = k.reshape(B, M, MEM_HEADS, MEM_HEAD_DIM)
    v = v.reshape(B, M, MEM_HEADS, MEM_HEAD_DIM)
    s = jnp.einsum('bshd,bmhd->bhsm', q, k).astype(jnp.float32) * (MEM_HEAD_DIM ** -0.5)
    p = jax.nn.softmax(s, axis=-1)
    o = jnp.einsum('bhsm,bmhd->bshd', p.astype(v.dtype), v).reshape(B, S, D_MODEL)
    return o @ wo


def encoder(x, mem, weights):
    (ffn1_norm, ffn1_w_gu, ffn1_w_down, mix_norm, w_in, four_w, dn_conv, dn_A_log, dn_dt_bias,
     dn_out_norm, attn_q_norm, attn_k_norm, w_out, mem_norm_x, mem_norm_m, mem_wq, mem_wkv, mem_wo,
     ffn2_norm, ffn2_w_gu, ffn2_w_down, final_norm) = weights
    S = x.shape[1]
    cos, sin = axial_rope(S)
    for l in range(DEPTH):
        x = x + 0.5 * swiglu(rmsnorm(x, ffn1_norm[l]), ffn1_w_gu[l], ffn1_w_down[l])
        n = rmsnorm(x, mix_norm[l])
        z = n @ w_in[l]
        u_f, dn_qkv, dn_a, dn_b, dn_gate, a_q, a_k, a_v = split_cols(z, IN_SPLITS)
        y_f = fourier_mix(u_f, four_w[l])
        y_d = deltanet_mix(dn_qkv, dn_a, dn_b, dn_gate, dn_conv[l], dn_A_log[l], dn_dt_bias[l], dn_out_norm[l])
        y_a = gqa_attention(a_q, a_k, a_v, attn_q_norm[l], attn_k_norm[l], cos, sin)
        x = x + jnp.concatenate([y_f, y_d, y_a], axis=-1) @ w_out[l]
        x = x + memory_cross_attention(rmsnorm(x, mem_norm_x[l]), rmsnorm(mem, mem_norm_m[l]),
                                       mem_wq[l], mem_wkv[l], mem_wo[l])
        x = x + 0.5 * swiglu(rmsnorm(x, ffn2_norm[l]), ffn2_w_gu[l], ffn2_w_down[l])
    return rmsnorm(x, final_norm)


def setup_inputs(seed: int = 0) -> dict:
    key = jax.random.key(seed)
    ks = jax.random.split(key, 32)
    f32 = jnp.float32
    L = DEPTH

    def dense(k, shape, fan_in):
        return jax.random.normal(k, shape, f32) * (fan_in ** -0.5)

    def gain(k, shape):
        return 1.0 + 0.02 * jax.random.normal(k, shape, f32)

    dt = jnp.exp(jax.random.uniform(ks[10], (L, 2, DN_HEADS), f32, math.log(1e-3), math.log(1e-1)))
    return {
        'x_prompt': jax.random.normal(ks[0], (BATCH, SEQ, D_MODEL), f32),
        'x_sample': jax.random.normal(ks[1], (DEC_BATCH, DEC_SEQ, D_MODEL), f32),
        'mem_prompt': jax.random.normal(ks[2], (BATCH, MEM_TOKENS, D_MODEL), f32),
        'mem_sample': jax.random.normal(ks[3], (DEC_BATCH, MEM_TOKENS, D_MODEL), f32),
        'ffn1_norm': gain(ks[4], (L, D_MODEL)),
        'ffn1_w_gu': dense(ks[5], (L, D_MODEL, 2 * D_FF), D_MODEL),
        'ffn1_w_down': dense(ks[6], (L, D_FF, D_MODEL), D_FF),
        'mix_norm': gain(ks[7], (L, D_MODEL)),
        'w_in': dense(ks[8], (L, D_MODEL, IN_WIDTH), D_MODEL),
        'four_w': dense(ks[9], (L, FOUR_GROUPS, FOUR_DIM, FOUR_DIM), FOUR_DIM),
        'dn_conv': dense(ks[11], (L, CONV_W, 3 * DN_WIDTH), CONV_W),
        'dn_A_log': jnp.log(jax.random.uniform(ks[12], (L, 2, DN_HEADS), f32, 1.0, 16.0)),
        'dn_dt_bias': dt + jnp.log(-jnp.expm1(-dt)),
        'dn_out_norm': gain(ks[13], (L, DN_HEAD_DIM)),
        'attn_q_norm': gain(ks[14], (L, HEAD_DIM)),
        'attn_k_norm': gain(ks[15], (L, HEAD_DIM)),
        'w_out': dense(ks[16], (L, MIX_WIDTH, D_MODEL), MIX_WIDTH),
        'mem_norm_x': gain(ks[17], (L, D_MODEL)),
        'mem_norm_m': gain(ks[18], (L, D_MODEL)),
        'mem_wq': dense(ks[19], (L, D_MODEL, D_MODEL), D_MODEL),
        'mem_wkv': dense(ks[20], (L, D_MODEL, 2 * D_MODEL), D_MODEL),
        'mem_wo': dense(ks[21], (L, D_MODEL, D_MODEL), D_MODEL),
        'ffn2_norm': gain(ks[22], (L, D_MODEL)),
        'ffn2_w_gu': dense(ks[23], (L, D_MODEL, 2 * D_FF), D_MODEL),
        'ffn2_w_down': dense(ks[24], (L, D_FF, D_MODEL), D_FF),
        'final_norm': gain(ks[25], (D_MODEL,)),
    }


def reference(x_prompt, x_sample, mem_prompt, mem_sample, ffn1_norm, ffn1_w_gu, ffn1_w_down, mix_norm,
              w_in, four_w, dn_conv, dn_A_log, dn_dt_bias, dn_out_norm, attn_q_norm, attn_k_norm, w_out,
              mem_norm_x, mem_norm_m, mem_wq, mem_wkv, mem_wo, ffn2_norm, ffn2_w_gu, ffn2_w_down, final_norm):
    weights = (ffn1_norm, ffn1_w_gu, ffn1_w_down, mix_norm, w_in, four_w, dn_conv, dn_A_log, dn_dt_bias,
               dn_out_norm, attn_q_norm, attn_k_norm, w_out, mem_norm_x, mem_norm_m, mem_wq, mem_wkv, mem_wo,
               ffn2_norm, ffn2_w_gu, ffn2_w_down, final_norm)
    y_prompt = encoder(x_prompt, mem_prompt, weights)
    y_sample = encoder(x_sample, mem_sample, weights)
    return (y_prompt, y_sample)
```

```cpp
#define EN_MIX 1
#ifndef REP_SYNC
#define REP_SYNC 0
#endif
#ifndef REP_GU
#define REP_GU 1
#endif
#ifndef REP_PREP
#define REP_PREP 1
#endif
#ifndef REP_SCAN
#define REP_SCAN 1
#endif
#ifndef REP_ATT
#define REP_ATT 1
#endif
#define EN_DN 1
#define EN_ATT 1
#define EN_DFT 1
#define EN_CROSS 1
#define EN_FFN 1
#include <hip/hip_runtime.h>
#include <hip/hip_cooperative_groups.h>
#include <cstdio>
#include <cstdint>
namespace cg = cooperative_groups;

#define LAS __attribute__((address_space(3)))
typedef unsigned short bf16_t;
typedef short bf16x8 __attribute__((ext_vector_type(8)));
typedef float f32x4 __attribute__((ext_vector_type(4)));
typedef float f32x16 __attribute__((ext_vector_type(16)));
typedef unsigned u32x4 __attribute__((ext_vector_type(4)));
typedef unsigned u32x2 __attribute__((ext_vector_type(2)));

#define LDS_WAIT() asm volatile("s_waitcnt lgkmcnt(0)" ::: "memory")
#define LDS_BAR() asm volatile("s_waitcnt lgkmcnt(0)\n\ts_barrier" ::: "memory")

typedef float f32x2_t __attribute__((ext_vector_type(2))); typedef __bf16 bf16x2_t __attribute__((ext_vector_type(2)));
__device__ __forceinline__ unsigned cvt_pk_bf16(float lo, float hi) { const f32x2_t v = {lo, hi}; const bf16x2_t b = __builtin_convertvector(v, bf16x2_t); return __builtin_bit_cast(unsigned, b); }
__device__ __forceinline__ bf16_t f2bf(float f) { return (bf16_t)(cvt_pk_bf16(f, f) & 0xffffu); }
__device__ __forceinline__ float bf2f(unsigned h) { return __uint_as_float(h << 16); }
__device__ __forceinline__ float bflo(unsigned w) { return __uint_as_float(w << 16); }
__device__ __forceinline__ float bfhi(unsigned w) { return __uint_as_float(w & 0xffff0000u); }
__device__ __forceinline__ float shx(float v, int mask, int lane) { return __int_as_float(__builtin_amdgcn_ds_bpermute((lane ^ mask) << 2, __float_as_int(v))); }
__device__ __forceinline__ float wave_sum(float v, int lane) {
#pragma unroll
    for (int o = 1; o < 64; o <<= 1) v += shx(v, o, lane);
    return v;
}
__device__ __forceinline__ int otid() { int t = threadIdx.x; asm volatile("" : "+v"(t)); return t; }
__device__ __forceinline__ int obid() { int t = blockIdx.x; asm volatile("" : "+s"(t)); return t; }
__device__ __forceinline__ int crow(int r, int hi) { return (r & 3) + 8 * (r >> 2) + 4 * hi; }
__device__ __forceinline__ int pos16(int e) { return (((e >> 2) & 1) << 3) | (((e >> 3) & 1) << 2) | (e & 3); }
__device__ __forceinline__ bf16x8 pack8(float a0, float a1, float a2, float a3, float a4, float a5, float a6, float a7) {
    u32x4 w; w.x = cvt_pk_bf16(a0, a1); w.y = cvt_pk_bf16(a2, a3); w.z = cvt_pk_bf16(a4, a5); w.w = cvt_pk_bf16(a6, a7);
    return __builtin_bit_cast(bf16x8, w);
}
__device__ __forceinline__ float row_rstd(const float* ssq, int row) {
    const f32x4* p = (const f32x4*)(ssq + (size_t)row * 16);
    const f32x4 a = p[0], b = p[1], c = p[2], d = p[3];
    const float s = ((a.x + a.y) + (a.z + a.w)) + ((b.x + b.y) + (b.z + b.w)) + ((c.x + c.y) + (c.z + c.w)) + ((d.x + d.y) + (d.z + d.w));
    return rsqrtf(s * (1.0f / 1024.0f) + 1e-6f);
}

__device__ __forceinline__ void load_rstd8(const float* ssq, int row0, int fq, int lane, float (&rs)[8]) {
    f32x4 v[8];
#pragma unroll
    for (int g = 0; g < 8; ++g) v[g] = *(const f32x4*)(ssq + (size_t)(row0 + (g >> 2) * 128 + (g & 3) * 16) * 16 + fq * 4);
#pragma unroll
    for (int g = 0; g < 8; ++g) { float t = (v[g][0] + v[g][1]) + (v[g][2] + v[g][3]); t += shx(t, 16, lane); t += shx(t, 32, lane); rs[g] = rsqrtf(t * (1.0f / 1024.0f) + 1e-6f); }
}
namespace pg8 {
constexpr int BM = 256, BK = 64, HALF = 128, HTB = HALF * BK * 2, STAGE_BYTES = 8 * HTB, NXCD = 8, WGM = 8;
__host__ __device__ __forceinline__ int lds_byte(int r, int c) { const int st = (r >> 4) * 2 + (c >> 5), rr = r & 15, cc = c & 31, ob = rr * 64 + cc * 2; return st * 1024 + (ob ^ (((ob >> 9) & 1) << 5)); }
__host__ __device__ __forceinline__ void stage_rc(int b, int& R, int& C) { const int st = b / 1024, sb = b % 1024, swz = sb ^ (((sb >> 9) & 1) << 5); R = (st >> 1) * 16 + swz / 64; C = (st & 1) * 32 + (swz % 64) / 2; }
__host__ __device__ __forceinline__ int perm32(int rho) { const int n = rho >> 4, i = rho & 15; return 8 * (i >> 2) + 4 * n + (i & 3); }

struct Unit { int pm, pn; };
struct Gemm { const bf16_t* A; const bf16_t* Bt; int K, lda, ldb; };

struct StaticOrder {
    int nM, nN, nwg, G, c, rev;
    __device__ void init(int nM_, int nN_, int G_, int c_, int rev_ = 0) { nM = nM_; nN = nN_; nwg = nM * nN; G = G_; c = c_; rev = rev_; }
    __device__ bool next(int i, Unit& u) const {
        const long L = (long)i * G + c; if (L >= nwg) return false;
        int wgid = (int)L; { const int q = nwg / NXCD, r = nwg % NXCD, xcd = wgid % NXCD, off = wgid / NXCD; wgid = (xcd < r ? xcd * (q + 1) : r * (q + 1) + (xcd - r) * q) + off; }
        if (rev) wgid = nwg - 1 - wgid;
        const int nig = WGM * nN, gid = wgid / nig, fm = gid * WGM, gsz = (nM - fm) < WGM ? (nM - fm) : WGM;
        u.pm = fm + ((wgid % nig) % gsz); u.pn = (wgid % nig) / gsz; return true;
    }
};

struct AddrStd { __device__ __forceinline__ void get(const Gemm& g, const Unit& u, const char*& a, const char*& b) const {
    a = (const char*)g.A + (size_t)u.pm * 256 * g.lda * 2; b = (const char*)g.Bt + (size_t)u.pn * 256 * g.ldb * 2; } };
struct AddrBatchB { int lgtpb; __device__ __forceinline__ void get(const Gemm& g, const Unit& u, const char*& a, const char*& b) const {
    a = (const char*)g.A + (size_t)u.pm * 256 * g.lda * 2; b = (const char*)g.Bt + ((size_t)(u.pm >> lgtpb) * 1048576 + (size_t)u.pn * 256 * 1024) * 2; } };
struct AddrFoldK { __device__ __forceinline__ void get(const Gemm& g, const Unit& u, const char*& a, const char*& b) const {
    a = (const char*)g.A + ((size_t)(u.pm >> 2) * 256 * 2048 + (size_t)(u.pm & 3) * 256) * 2; b = (const char*)g.Bt + ((size_t)u.pn * 256 * 1024 + (size_t)(u.pm & 3) * 256) * 2; } };
struct AddrFoldV { __device__ __forceinline__ void get(const Gemm& g, const Unit& u, const char*& a, const char*& b) const {
    a = (const char*)g.A + ((size_t)u.pm * 256 * 1024 + (size_t)(u.pn & 3) * 256) * 2; b = (const char*)g.Bt + ((size_t)(u.pn >> 2) * 256 * 2048 + 1024 + (size_t)(u.pn & 3) * 256) * 2; } };

typedef f32x4 Acc[2][2][4][2];

struct EpiSwiglu {
    static constexpr bool PERM = true;
    bf16_t* H; const float* ssq;
    __device__ __forceinline__ void operator()(Acc& acc, const Unit& u, int wr, int wc, int fr, int fq, LAS unsigned char* xch) const {
        const int row0 = u.pm * 256 + wr * 64 + fr, col0 = u.pn * 128 + wc * 32 + 8 * fq;
        float rs8[8]; load_rstd8(ssq, row0, fq, fq * 16 + fr, rs8);
#pragma unroll
        for (int ai = 0; ai < 2; ++ai)
#pragma unroll
            for (int m = 0; m < 4; ++m) {
                const int row = row0 + ai * 128 + m * 16; const float rs = rs8[ai * 4 + m];
                float hv[8];
#pragma unroll
                for (int n = 0; n < 2; ++n)
#pragma unroll
                    for (int j = 0; j < 4; ++j) { const float g = acc[ai][0][m][n][j] * rs, uu = acc[ai][1][m][n][j] * rs;
                        hv[n * 4 + j] = g * __builtin_amdgcn_rcpf(1.0f + __expf(-g)) * uu; }
                u32x4 w; w.x = cvt_pk_bf16(hv[0], hv[1]); w.y = cvt_pk_bf16(hv[2], hv[3]); w.z = cvt_pk_bf16(hv[4], hv[5]); w.w = cvt_pk_bf16(hv[6], hv[7]);
                *(u32x4*)(H + (size_t)row * 2816 + col0) = w; asm volatile("" ::: "memory");
            }
    }
};
struct EpiRes {
    static constexpr bool PERM = false; static constexpr int PD = 3;
    const float* Xb; float* X; bf16_t* XB; float* ssq; float alpha;
    __device__ __forceinline__ void operator()(Acc& acc, const Unit& u, int wr, int wc, int fr, int fq, LAS unsigned char* xch) const {
        const int row0 = u.pm * 256 + wr * 64 + fr, col0 = u.pn * 256 + wc * 32 + 4 * fq;
        f32x4 pre[PD][4];
#pragma unroll
        for (int g = 0; g < PD; ++g) { const float* xr = Xb + (size_t)(row0 + (g >> 2) * 128 + (g & 3) * 16) * 1024 + col0;
#pragma unroll
            for (int q = 0; q < 4; ++q) pre[g][q] = *(const f32x4*)(xr + (q >> 1) * 128 + (q & 1) * 16); }
#pragma unroll
        for (int g = 0; g < 8; ++g) {
            const int ai = g >> 2, m = g & 3; const int row = row0 + ai * 128 + m * 16; float s = 0.f;
            float* xr = X + (size_t)row * 1024 + col0; bf16_t* br = XB + (size_t)row * 1024 + col0;
            f32x4 v[4];
#pragma unroll
            for (int q = 0; q < 4; ++q) v[q] = pre[g % PD][q] + acc[ai][q >> 1][m][q & 1] * alpha;
            if (g + PD < 8) { const int gn = g + PD; const float* xn = Xb + (size_t)(row0 + (gn >> 2) * 128 + (gn & 3) * 16) * 1024 + col0;
#pragma unroll
                for (int q = 0; q < 4; ++q) pre[g % PD][q] = *(const f32x4*)(xn + (q >> 1) * 128 + (q & 1) * 16); }
#pragma unroll
            for (int q = 0; q < 4; ++q) {
                *(f32x4*)(xr + (q >> 1) * 128 + (q & 1) * 16) = v[q];
                u32x2 w; w.x = cvt_pk_bf16(v[q][0], v[q][1]); w.y = cvt_pk_bf16(v[q][2], v[q][3]); *(u32x2*)(br + (q >> 1) * 128 + (q & 1) * 16) = w;
                s += (v[q][0] * v[q][0] + v[q][1] * v[q][1]) + (v[q][2] * v[q][2] + v[q][3] * v[q][3]);
            }
            s += shx(s, 16, fq * 16 + fr); s += shx(s, 32, fq * 16 + fr);
            if (fq == 0) ssq[(size_t)row * 16 + u.pn * 4 + wc] = s;
            asm volatile("" ::: "memory");
        }
    }
};
template <int MODE> struct EpiBf16 {
    static constexpr bool PERM = true;
    bf16_t* O; int ld; const float* ssq; float scale; int S;
    __device__ __forceinline__ void operator()(Acc& acc, const Unit& u, int wr, int wc, int fr, int fq, LAS unsigned char* xch) const {
        int rowb, colb;
        if (MODE == 0) { rowb = u.pm * 256; colb = u.pn * 256; } else if (MODE == 1) { rowb = (u.pn >> 2) * 1024 + u.pm * 256; colb = (u.pn & 3) * 256; } else { rowb = u.pn * S + u.pm * 256; colb = 0; }
        const int rl0 = wr * 64 + fr, col0 = colb + wc * 32 + 8 * fq;
        float rs8[8];
        if (ssq) load_rstd8(ssq, u.pm * 256 + rl0, fq, fq * 16 + fr, rs8);
#pragma unroll
        for (int ai = 0; ai < 2; ++ai)
#pragma unroll
            for (int m = 0; m < 4; ++m) {
                const int rl = rl0 + ai * 128 + m * 16; float rs = scale; if (ssq) rs *= rs8[ai * 4 + m];
                bf16_t* rowp = O + (size_t)(rowb + rl) * ld + col0;
#pragma unroll
                for (int bj = 0; bj < 2; ++bj) { const f32x4 v0 = acc[ai][bj][m][0] * rs, v1 = acc[ai][bj][m][1] * rs;
                    u32x4 w; w.x = cvt_pk_bf16(v0[0], v0[1]); w.y = cvt_pk_bf16(v0[2], v0[3]); w.z = cvt_pk_bf16(v1[0], v1[1]); w.w = cvt_pk_bf16(v1[2], v1[3]);
                    *(u32x4*)(rowp + bj * 128) = w; } asm volatile("" ::: "memory");
            }
    }
};
struct EpiWin {
    static constexpr bool PERM = true;
    bf16_t* Z; bf16_t* FT; bf16_t* VT; float* AB; const float* ssq; int S, lgS;
    __device__ __forceinline__ void operator()(Acc& acc, const Unit& u, int wr, int wc, int fr, int fq, LAS unsigned char* xch) const {
        const int pn = u.pn; const int row0 = u.pm * 256 + wr * 64 + fr;
        float rs8[8]; load_rstd8(ssq, row0, fq, fq * 16 + fr, rs8);
#pragma unroll
        for (int ai = 0; ai < 2; ++ai)
#pragma unroll
            for (int m = 0; m < 4; ++m) {
                const int row = row0 + ai * 128 + m * 16; const float rs = rs8[ai * 4 + m];
                const int b = row >> lgS, nloc = row & (S - 1);
#pragma unroll
                for (int bj = 0; bj < 2; ++bj) {
                    const f32x4 v0 = acc[ai][bj][m][0] * rs, v1 = acc[ai][bj][m][1] * rs; const int cl = bj * 128 + wc * 32 + 8 * fq;
                    const float vv[8] = {v0[0], v0[1], v0[2], v0[3], v1[0], v1[1], v1[2], v1[3]};
                    if (pn < 7 && !(pn == 2 && bj == 1)) {
                        u32x4 w; w.x = cvt_pk_bf16(vv[0], vv[1]); w.y = cvt_pk_bf16(vv[2], vv[3]); w.z = cvt_pk_bf16(vv[4], vv[5]); w.w = cvt_pk_bf16(vv[6], vv[7]);
                        *(u32x4*)(Z + (size_t)row * 2048 + pn * 256 + cl) = w;
                    } else if (pn == 2) {
                        const int cv = cl - 128;
#pragma unroll
                        for (int e = 0; e < 8; ++e) VT[((size_t)(b * 128 + cv + e) << lgS) + nloc] = f2bf(vv[e]);
                    } else if (pn == 7) {
                        if (cl < 16) { *(f32x4*)(AB + (size_t)row * 16 + cl) = v0; *(f32x4*)(AB + (size_t)row * 16 + cl + 4) = v1; }
                    } else {
                        const int part = pn - 8;
#pragma unroll
                        for (int e = 0; e < 8; ++e) FT[((size_t)(b * 256 + cl + e) << (lgS + 1)) + ((size_t)part << lgS) + nloc] = f2bf(vv[e]);
                    }
                } asm volatile("" ::: "memory");
            }
    }
};
struct EpiSoftmax {
    static constexpr bool PERM = true;
    bf16_t* P; const float* ssq;
    __device__ __forceinline__ void operator()(Acc& acc, const Unit& u, int wr, int wc, int fr, int fq, LAS unsigned char* xch) const {
        LAS float* xm = (LAS float*)xch; LAS float* xs = xm + 1024;
        const int rl0 = wr * 64 + fr;
        float rs8[8]; load_rstd8(ssq, u.pm * 256 + rl0, fq, fq * 16 + fr, rs8);
#pragma unroll
        for (int ai = 0; ai < 2; ++ai)
#pragma unroll
            for (int m = 0; m < 4; ++m) {
                const int rl = rl0 + ai * 128 + m * 16; const float rs = rs8[ai * 4 + m]; float mx = -INFINITY;
#pragma unroll
                for (int bj = 0; bj < 2; ++bj)
#pragma unroll
                    for (int n = 0; n < 2; ++n) { const f32x4 v = acc[ai][bj][m][n] * rs; acc[ai][bj][m][n] = v; mx = fmaxf(mx, fmaxf(fmaxf(v[0], v[1]), fmaxf(v[2], v[3]))); }
                mx = fmaxf(mx, shx(mx, 16, fq * 16 + fr)); mx = fmaxf(mx, shx(mx, 32, fq * 16 + fr));
                if (fq == 0) xm[rl * 4 + wc] = mx; asm volatile("" ::: "memory");
            }
        LDS_BAR();
#pragma unroll
        for (int ai = 0; ai < 2; ++ai)
#pragma unroll
            for (int m = 0; m < 4; ++m) {
                const int rl = rl0 + ai * 128 + m * 16; const f32x4 q = *(LAS f32x4*)(xm + rl * 4);
                const float mx = fmaxf(fmaxf(q[0], q[1]), fmaxf(q[2], q[3])); float s = 0.f;
#pragma unroll
                for (int bj = 0; bj < 2; ++bj)
#pragma unroll
                    for (int n = 0; n < 2; ++n) { f32x4 v = acc[ai][bj][m][n];
#pragma unroll
                        for (int j = 0; j < 4; ++j) v[j] = __builtin_amdgcn_exp2f(v[j] - mx);
                        acc[ai][bj][m][n] = v; s += (v[0] + v[1]) + (v[2] + v[3]); }
                s += shx(s, 16, fq * 16 + fr); s += shx(s, 32, fq * 16 + fr);
                if (fq == 0) xs[rl * 4 + wc] = s; asm volatile("" ::: "memory");
            }
        LDS_BAR();
        const int col0 = u.pn * 256 + wc * 32 + 8 * fq;
#pragma unroll
        for (int ai = 0; ai < 2; ++ai)
#pragma unroll
            for (int m = 0; m < 4; ++m) {
                const int rl = rl0 + ai * 128 + m * 16; const f32x4 q = *(LAS f32x4*)(xs + rl * 4);
                const float inv = 1.0f / ((q[0] + q[1]) + (q[2] + q[3]));
                bf16_t* rowp = P + (size_t)(u.pm * 256 + rl) * 1024 + col0;
#pragma unroll
                for (int bj = 0; bj < 2; ++bj) { const f32x4 v0 = acc[ai][bj][m][0] * inv, v1 = acc[ai][bj][m][1] * inv;
                    u32x4 w; w.x = cvt_pk_bf16(v0[0], v0[1]); w.y = cvt_pk_bf16(v0[2], v0[3]); w.z = cvt_pk_bf16(v1[0], v1[1]); w.w = cvt_pk_bf16(v1[2], v1[3]);
                    *(u32x4*)(rowp + bj * 128) = w; } asm volatile("" ::: "memory");
            }
    }
};

template <class Epi, class Addr>
__device__ __forceinline__ void gemm_phase(LAS unsigned char* lds, const Gemm g, const StaticOrder& S, const Addr& AD, const Epi& E) {
    const int tid = otid(), wid = __builtin_amdgcn_readfirstlane(tid >> 6), lane = tid & 63, wr = wid >> 2, wc = wid & 3, fr = lane & 15, fq = lane >> 4;
    int Kq = g.K; asm volatile("" : "+s"(Kq));
    const int nt = Kq / BK;
    unsigned voffA[2], voffB[2];
#pragma unroll
    for (int i = 0; i < 2; ++i) { int R, C; stage_rc(tid * 16 + i * 8192, R, C); const int Rb = Epi::PERM ? ((R & ~31) + perm32(R & 31)) : R;
        voffA[i] = (unsigned)(R * g.lda + C) * 2u; voffB[i] = (unsigned)(Rb * g.ldb + C) * 2u; }
    const size_t kstep = (size_t)(BK * 2);
    const size_t hstepA = (size_t)HALF * g.lda * 2, hstepB = (size_t)HALF * g.ldb * 2;
    const unsigned ldsw = (unsigned)wid * 1024u;
    const int aoff = lds_byte(wr * 64 + fr, fq * 8), boff = lds_byte(wc * 32 + fr, fq * 8);
    LAS unsigned char* xch = lds + STAGE_BYTES;
#define PG8_SA(b, h) (((b) * 2 + (h)) * HTB)
#define PG8_SB(b, h) ((4 + (b) * 2 + (h)) * HTB)
#define PG8_STAGE(bufoff, gbase, voff) do { _Pragma("unroll") for (int _i = 0; _i < 2; ++_i) \
        __builtin_amdgcn_global_load_lds((const unsigned*)((const char*)(gbase) + (voff)[_i]), (LAS unsigned*)(lds + (bufoff) + ldsw + _i * 8192), 16, 0, 0); } while (0)
#define PG8_LDA(dst, b, h) do { _Pragma("unroll") for (int m = 0; m < 4; ++m) _Pragma("unroll") for (int k = 0; k < 2; ++k) dst[m][k] = *(const LAS bf16x8*)(lds + PG8_SA(b, h) + aoff + m * 2048 + k * 1024); } while (0)
#define PG8_LDB(dst, b, h) do { _Pragma("unroll") for (int n = 0; n < 2; ++n) _Pragma("unroll") for (int k = 0; k < 2; ++k) dst[n][k] = *(const LAS bf16x8*)(lds + PG8_SB(b, h) + boff + n * 2048 + k * 1024); } while (0)
#define PG8_MMA(ai, bj, At, Bt) do { __builtin_amdgcn_s_setprio(1); _Pragma("unroll") for (int m = 0; m < 4; ++m) _Pragma("unroll") for (int n = 0; n < 2; ++n) _Pragma("unroll") for (int k = 0; k < 2; ++k) \
        acc[ai][bj][m][n] = __builtin_amdgcn_mfma_f32_16x16x32_bf16(Bt[n][k], At[m][k], acc[ai][bj][m][n], 0, 0, 0); __builtin_amdgcn_s_setprio(0); } while (0)
#define PG8_WAIT_V(n) asm volatile("s_waitcnt vmcnt(" #n ")" ::: "memory")
#define PG8_WAIT_L(n) asm volatile("s_waitcnt lgkmcnt(" #n ")" ::: "memory")
#define PG8_BAR __builtin_amdgcn_s_barrier()
#define PG8_SCHED __builtin_amdgcn_sched_barrier(0)
    Unit cur, nxt; int ui = 0;
    if (!S.next(0, cur)) return;
    Acc acc;
#pragma unroll
    for (int a = 0; a < 2; ++a)
#pragma unroll
        for (int b = 0; b < 2; ++b)
#pragma unroll
            for (int m = 0; m < 4; ++m)
#pragma unroll
                for (int n = 0; n < 2; ++n) acc[a][b][m][n] = (f32x4){0.f, 0.f, 0.f, 0.f};
    bf16x8 At[4][2], B0[2][2], B1[2][2];
    const char* cA; const char* cB; AD.get(g, cur, cA, cB);
    PG8_STAGE(PG8_SB(0, 0), cB, voffB); PG8_STAGE(PG8_SB(0, 1), cB + hstepB, voffB); PG8_STAGE(PG8_SA(0, 0), cA, voffA); PG8_STAGE(PG8_SA(0, 1), cA + hstepA, voffA);
    if (wr == 1) PG8_BAR;
    PG8_WAIT_V(2); PG8_BAR;
    PG8_STAGE(PG8_SB(1, 0), cB + kstep, voffB); PG8_STAGE(PG8_SA(1, 0), cA + kstep, voffA); PG8_STAGE(PG8_SB(1, 1), cB + hstepB + kstep, voffB);
    PG8_WAIT_V(6); PG8_BAR;
    for (;;) {
        const bool has_next = S.next(ui + 1, nxt);
        const char* nA = cA; const char* nB = cB; if (has_next) AD.get(g, nxt, nA, nB);
        for (int t = 0; t < nt; t += 2) {
            const bool last = (t == nt - 2);
            const char* a1 = cA + (size_t)(t + 1) * kstep;
            const char* a2 = last ? nA : cA + (size_t)(t + 2) * kstep; const char* b2 = last ? nB : cB + (size_t)(t + 2) * kstep;
            const char* a3 = a2 + kstep; const char* b3 = b2 + kstep;
            PG8_LDB(B0, 0, 0); PG8_LDB(B1, 0, 1); PG8_SCHED; PG8_LDA(At, 0, 0); PG8_STAGE(PG8_SA(1, 1), a1 + hstepA, voffA);
            PG8_WAIT_V(8); PG8_WAIT_L(0); PG8_BAR; PG8_MMA(0, 0, At, B0); PG8_MMA(0, 1, At, B1); PG8_BAR; PG8_SCHED;
            PG8_LDA(At, 0, 1); PG8_STAGE(PG8_SB(0, 0), b2, voffB); PG8_STAGE(PG8_SB(0, 1), b2 + hstepB, voffB); PG8_STAGE(PG8_SA(0, 0), a2, voffA);
            PG8_WAIT_V(8); PG8_WAIT_L(0); PG8_BAR; PG8_MMA(1, 0, At, B0); PG8_MMA(1, 1, At, B1); PG8_BAR; PG8_SCHED;
            PG8_LDB(B0, 1, 0); PG8_LDB(B1, 1, 1); PG8_SCHED; PG8_LDA(At, 1, 0); PG8_STAGE(PG8_SA(0, 1), a2 + hstepA, voffA);
            PG8_WAIT_V(8); PG8_WAIT_L(0); PG8_BAR; PG8_MMA(0, 0, At, B0); PG8_MMA(0, 1, At, B1); PG8_BAR; PG8_SCHED;
            PG8_LDA(At, 1, 1); PG8_STAGE(PG8_SB(1, 0), b3, voffB); PG8_STAGE(PG8_SB(1, 1), b3 + hstepB, voffB); PG8_STAGE(PG8_SA(1, 0), a3, voffA);
            PG8_WAIT_V(8); PG8_WAIT_L(0); PG8_BAR; PG8_MMA(1, 0, At, B0); PG8_MMA(1, 1, At, B1); PG8_BAR; PG8_SCHED;
        }
        if (wr == 0) PG8_BAR;
        { int fr_ = fr, fq_ = fq; asm volatile("" : "+v"(fr_), "+v"(fq_));
          E(acc, cur, wr, wc, fr_, fq_, xch); }
        if (!has_next) break;
#pragma unroll
        for (int a = 0; a < 2; ++a)
#pragma unroll
            for (int b = 0; b < 2; ++b)
#pragma unroll
                for (int m = 0; m < 4; ++m)
#pragma unroll
                    for (int n = 0; n < 2; ++n) acc[a][b][m][n] = (f32x4){0.f, 0.f, 0.f, 0.f};
        cur = nxt; cA = nA; cB = nB; ++ui;
        if (wr == 1) PG8_BAR;
    }
    PG8_WAIT_V(0);
    PG8_BAR;
#undef PG8_SA
#undef PG8_SB
#undef PG8_STAGE
#undef PG8_LDA
#undef PG8_LDB
#undef PG8_MMA
#undef PG8_WAIT_V
#undef PG8_WAIT_L
#undef PG8_BAR
#undef PG8_SCHED
}
}

constexpr int NTOK = 65536;
constexpr size_t MiB = 1u << 20;
constexpr size_t WS_SSQ = 0, WS_MSSQ = 4 * MiB, WS_PQ = 5 * MiB, WS_GL = 5 * MiB + 512 * 1024, WS_CNT = 6 * MiB;
constexpr size_t WS_W = 8 * MiB, WS_X1 = 56 * MiB, WS_YC = 184 * MiB, WS_BIG = 312 * MiB, WS_DN = 664 * MiB, WS_DFT2 = 984 * MiB, WS_MEMB = 1000 * MiB, WS_AB = 1016 * MiB, WS_END = 1020 * MiB;
constexpr size_t BG_Z = 0, BG_FT = 256 * MiB, BG_VT = 320 * MiB;
constexpr size_t BG_P = 0, BG_WKT = 128 * MiB, BG_VWT = 192 * MiB, BG_KV = 256 * MiB;
constexpr size_t W_GU1 = 0, W_D1 = 5767168, W_IN = 8650752, W_OUT = 11272192, W_QB = 12320768, W_KV = 13369344, W_OT = 15466496, W_GU2 = 16515072, W_D2 = 22282240;
#ifndef PHASE_SEL
#define PHASE_SEL -1
#endif
#define PH(n) (PHASE_SEL < 0 || PHASE_SEL == (n))
constexpr int LDS_BYTES = 147456;
constexpr int XCH_OFF = 131072, CNT_OFF = 140000, XB_LDS_OFF = 143360;
constexpr float QSCALE_GQA = 0.125f * 1.4426950408889634f;
constexpr float QSCALE_MEM = 0.0625f * 1.4426950408889634f;

struct Params { const float* in[26]; float* out; unsigned char* ws; };
typedef __attribute__((address_space(1))) unsigned char gu8_t;
__device__ __forceinline__ unsigned char* ows(const Params& p) { gu8_t* w = (gu8_t*)p.ws; asm volatile("" : "+s"(w)); return (unsigned char*)w; }

__device__ __forceinline__ void phase_init(const Params& p, int grp, int S, int lgS, int B, float* X, bf16_t* DFT) {
    unsigned char* const ws_ = ows(p);
    const int tid = otid(), lane = tid & 63, wid = tid >> 6;
    const int gw = obid() * 8 + wid, NGW = gridDim.x * 8;
    unsigned char* ws = ws_;
    const float* xin = p.in[grp]; bf16_t* X1 = (bf16_t*)(ws + WS_X1); float* ssq = (float*)(ws + WS_SSQ);
    for (int row = gw; row < NTOK; row += NGW) {
        const f32x4* xr = (const f32x4*)(xin + (size_t)row * 1024) + lane; f32x4 v[4]; float s = 0.f;
#pragma unroll
        for (int j = 0; j < 4; ++j) { v[j] = xr[64 * j]; s += (v[j][0] * v[j][0] + v[j][1] * v[j][1]) + (v[j][2] * v[j][2] + v[j][3] * v[j][3]); }
        s = wave_sum(s, lane);
        u32x2* ob = (u32x2*)(X1 + (size_t)row * 1024) + lane;
#pragma unroll
        for (int j = 0; j < 4; ++j) { u32x2 w; w.x = cvt_pk_bf16(v[j][0], v[j][1]); w.y = cvt_pk_bf16(v[j][2], v[j][3]); ob[64 * j] = w; }
        if (lane < 16) ssq[(size_t)row * 16 + lane] = (lane == 0) ? s : 0.f;
    }
    const float* memin = p.in[2 + grp]; bf16_t* MB = (bf16_t*)(ws + WS_MEMB); float* mssq = (float*)(ws + WS_MSSQ);
    for (int row = gw; row < B * 256; row += NGW) {
        const f32x4* xr = (const f32x4*)(memin + (size_t)row * 1024) + lane; f32x4 v[4]; float s = 0.f;
#pragma unroll
        for (int j = 0; j < 4; ++j) { v[j] = xr[64 * j]; s += (v[j][0] * v[j][0] + v[j][1] * v[j][1]) + (v[j][2] * v[j][2] + v[j][3] * v[j][3]); }
        s = wave_sum(s, lane);
        u32x2* ob = (u32x2*)(MB + (size_t)row * 1024) + lane;
#pragma unroll
        for (int j = 0; j < 4; ++j) { u32x2 w; w.x = cvt_pk_bf16(v[j][0], v[j][1]); w.y = cvt_pk_bf16(v[j][2], v[j][3]); ob[64 * j] = w; }
        if (lane < 16) mssq[(size_t)row * 16 + lane] = (lane == 0) ? s : 0.f;
    }
    const size_t nvec = ((size_t)S * (size_t)S) >> 3; const size_t NT = (size_t)gridDim.x * 512;
    const float invS = 1.0f / (float)S; const int hS = S >> 1;
    for (size_t i = (size_t)obid() * 512 + tid; i < nvec; i += NT) {
        const int j = (int)(i >> (lgS - 3)); const int c0 = (int)(i & (size_t)((S >> 3) - 1)) * 8;
        float v[8];
#pragma unroll
        for (int e = 0; e < 8; ++e) { const int k = c0 + e; const bool sn = k > hS; const int kk = sn ? k - hS : k; const int idx = (j * kk) & (S - 1); const float fr = (float)idx * invS;
            v[e] = sn ? -__builtin_amdgcn_sinf(fr) : __builtin_amdgcn_cosf(fr); }
        u32x4 w; w.x = cvt_pk_bf16(v[0], v[1]); w.y = cvt_pk_bf16(v[2], v[3]); w.z = cvt_pk_bf16(v[4], v[5]); w.w = cvt_pk_bf16(v[6], v[7]);
        *(u32x4*)(DFT + (size_t)j * S + c0) = w;
    }
}

__device__ __forceinline__ void phase_fold(const Params& p, int S, int lgS, int B, LAS unsigned char* lds) {
    unsigned char* const ws_ = ows(p);
    const int tid = otid(); bf16_t* FT = (bf16_t*)(ws_ + WS_BIG + BG_FT); const int hS = S >> 1;
    LAS bf16_t* rowl = (LAS bf16_t*)lds;
    for (int row = obid(); row < B * 256; row += gridDim.x) {
        bf16_t* rp = FT + (size_t)row * 2 * S;
        for (int c = tid; c < (S >> 2); c += 512) *(LAS u32x4*)(rowl + c * 8) = *(const u32x4*)(rp + c * 8);
        __syncthreads();
        for (int k = tid; k < S; k += 512) {
            float v;
            if (k <= hS) { v = bf2f(rowl[k]); if (k != 0 && k != hS) v += bf2f(rowl[S - k]); }
            else { const int kk = k - hS; v = bf2f(rowl[S + kk]) - bf2f(rowl[2 * S - kk]); }
            rp[k] = f2bf(v);
        }
        __syncthreads();
    }
}

__device__ __forceinline__ void phase_pq(const Params& p, int l) {
    unsigned char* const ws_ = ows(p);
    float* PQ = (float*)(ws_ + WS_PQ) + (size_t)l * 32768; const float* fw = p.in[9] + (size_t)l * 16384;
    for (int o = obid() * 512 + otid(); o < 32768; o += gridDim.x * 512) {
        const int part = o >> 14, g = (o >> 12) & 3, c = (o >> 6) & 63, d = o & 63; float acc = 0.f;
        for (int e = 0; e < 64; ++e) { const float fr = (float)((c * e) & 63) * (1.0f / 64.0f); const float t = part ? __builtin_amdgcn_sinf(fr) : __builtin_amdgcn_cosf(fr);
            acc += t * fw[(g * 64 + e) * 64 + d]; }
        PQ[o] = acc;
    }
}

__device__ __forceinline__ void tr_item(const float* W, int K, int Nsrc, int srccol, int nvalid, bf16_t* WT, int destrow0, const float* gain, LAS float* scr, int kb, int lane) {
    const int k0 = 64 * kb;
#pragma unroll 8
    for (int i = 0; i < 32; ++i) { const int kk = 2 * i + (lane >> 5); const int c = lane & 31;
        float v = (c < nvalid) ? W[(size_t)(k0 + kk) * Nsrc + srccol + c] : 0.f; if (gain) v *= gain[k0 + kk]; scr[kk * 33 + c] = v; }
    LDS_WAIT();
    const int c = lane & 7;
#pragma unroll
    for (int j = 0; j < 4; ++j) { const int n = (lane >> 3) + 8 * j; const LAS float* s = scr + (8 * c) * 33 + n;
        u32x4 o; o.x = cvt_pk_bf16(s[0 * 33], s[1 * 33]); o.y = cvt_pk_bf16(s[2 * 33], s[3 * 33]); o.z = cvt_pk_bf16(s[4 * 33], s[5 * 33]); o.w = cvt_pk_bf16(s[6 * 33], s[7 * 33]);
        *(u32x4*)(WT + (size_t)(destrow0 + n) * K + k0 + 8 * c) = o; }
    LDS_WAIT();
}
__device__ __forceinline__ void phase_weights(const Params& p, int l, LAS unsigned char* lds) {
    unsigned char* const ws_ = ows(p);
    const int tid = otid(), lane = tid & 63, wid = tid >> 6;
    const int gw = obid() * 8 + wid, NGW = gridDim.x * 8;
    LAS float* scr = (LAS float*)(lds + wid * 16384);
    bf16_t* W = (bf16_t*)(ws_ + WS_W);
    const float* ffn1n = p.in[4] + l * 1024; const float* gu1 = p.in[5] + (size_t)l * 1024 * 5632; const float* d1 = p.in[6] + (size_t)l * 2816 * 1024;
    const float* mixn = p.in[7] + l * 1024; const float* win = p.in[8] + (size_t)l * 1024 * 2064; const float* wout = p.in[16] + (size_t)l * 1048576;
    const float* mnx = p.in[17] + l * 1024; const float* mnm = p.in[18] + l * 1024; const float* wq = p.in[19] + (size_t)l * 1048576;
    const float* wkv = p.in[20] + (size_t)l * 2097152; const float* wo = p.in[21] + (size_t)l * 1048576;
    const float* ffn2n = p.in[22] + l * 1024; const float* gu2 = p.in[23] + (size_t)l * 1024 * 5632; const float* d2 = p.in[24] + (size_t)l * 2816 * 1024;
    for (int it = gw; it < 11520; it += NGW) {
        int r = it;
        if (r < 2816 || (r >= 7296 && r < 10112)) {
            const bool second = r >= 7296; if (second) r -= 7296;
            const int kb = r / 176, nb = r % 176, tile = nb >> 3, within = nb & 7, half = within >> 2, j32 = within & 3;
            tr_item(second ? gu2 : gu1, 1024, 5632, half * 2816 + tile * 128 + j32 * 32, 32, W + (second ? W_GU2 : W_GU1), nb * 32, second ? ffn2n : ffn1n, scr, kb, lane);
        } else if ((r >= 2816 && r < 4224) || r >= 10112) {
            const bool second = r >= 10112; r -= second ? 10112 : 2816;
            const int kb = r / 32, nb = r % 32;
            tr_item(second ? d2 : d1, 2816, 1024, nb * 32, 32, W + (second ? W_D2 : W_D1), nb * 32, nullptr, scr, kb, lane);
        } else if (r < 5248) {
            r -= 4224; const int kb = r / 64, nb = r % 64, d0 = nb * 32; int src, nv = 32;
            if (d0 < 512) src = 1296 + d0; else if (d0 < 640) src = 1808 + (d0 - 512); else if (d0 < 768) src = 1936 + (d0 - 640);
            else if (d0 < 1536) src = 256 + (d0 - 768); else if (d0 < 1792) src = 1040 + (d0 - 1536); else if (d0 == 1792) { src = 1024; nv = 16; } else { src = 0; nv = 0; }
            tr_item(win, 1024, 2064, src, nv, W + W_IN, d0, mixn, scr, kb, lane);
        } else if (r < 5760) { r -= 5248; tr_item(wout, 1024, 1024, (r % 32) * 32, 32, W + W_OUT, (r % 32) * 32, nullptr, scr, r / 32, lane);
        } else if (r < 6784) { r -= 5760; tr_item(wkv, 1024, 2048, (r % 64) * 32, 32, W + W_KV, (r % 64) * 32, mnm, scr, r / 64, lane);
        } else { r -= 6784; tr_item(wo, 1024, 1024, (r % 32) * 32, 32, W + W_OT, (r % 32) * 32, nullptr, scr, r / 32, lane); }
    }
    const float* PQ = (const float*)(ws_ + WS_PQ) + (size_t)l * 32768;
    for (int it = gw; it < 8192; it += NGW) {
        const int k = it >> 3, part = (it >> 2) & 1, g = it & 3; const float* wr = win + (size_t)k * 2064 + g * 64; const float* pq = PQ + ((part * 4 + g) * 64) * 64 + lane; float acc = 0.f;
#pragma unroll 8
        for (int c = 0; c < 64; ++c) acc += wr[c] * pq[c * 64];
        W[W_IN + (size_t)(2048 + part * 256 + g * 64 + lane) * 1024 + k] = f2bf(acc * mixn[k]);
    }
    for (int i = obid() * 512 + tid; i < 131072; i += gridDim.x * 512) {
        const int k = i >> 7, n0 = (i & 127) * 8; const float gsc = mnx[k] * QSCALE_MEM; const f32x4 a = *(const f32x4*)(wq + (size_t)k * 1024 + n0), b = *(const f32x4*)(wq + (size_t)k * 1024 + n0 + 4);
        u32x4 w; w.x = cvt_pk_bf16(a[0] * gsc, a[1] * gsc); w.y = cvt_pk_bf16(a[2] * gsc, a[3] * gsc); w.z = cvt_pk_bf16(b[0] * gsc, b[1] * gsc); w.w = cvt_pk_bf16(b[2] * gsc, b[3] * gsc);
        *(u32x4*)(W + W_QB + (size_t)k * 1024 + n0) = w;
    }
}

__device__ __forceinline__ void phase_qkrope(const Params& p, int l, int S, int lgS) {
    unsigned char* const ws_ = ows(p);
    bf16_t* Z = (bf16_t*)(ws_ + WS_BIG + BG_Z); const float* qn = p.in[14] + l * 64; const float* kn = p.in[15] + l * 64;
    const int total = NTOK * 40; const int tid = otid(), lane = tid & 63;
    for (int i = obid() * 512 + tid; i < total; i += gridDim.x * 512) {
        const int row = i / 40, rem = i - row * 40, head = rem >> 2, sub = rem & 3, axis = sub >> 1, fg = sub & 1;
        const bool isq = head < 8; const int colb = isq ? head * 64 : 512 + (head - 8) * 64; const float* nw = isq ? qn : kn;
        bf16_t* p1 = Z + (size_t)row * 2048 + colb + axis * 32 + fg * 8; bf16_t* p2 = p1 + 16;
        const u32x4 w1 = *(const u32x4*)p1, w2 = *(const u32x4*)p2;
        float x1[8], x2[8];
#pragma unroll
        for (int e = 0; e < 4; ++e) { x1[2 * e] = bflo(w1[e]); x1[2 * e + 1] = bfhi(w1[e]); x2[2 * e] = bflo(w2[e]); x2[2 * e + 1] = bfhi(w2[e]); }
        float ss = 0.f;
#pragma unroll
        for (int e = 0; e < 8; ++e) ss += x1[e] * x1[e] + x2[e] * x2[e];
        ss += shx(ss, 1, lane); ss += shx(ss, 2, lane);
        const float rs = rsqrtf(ss * (1.0f / 64.0f) + 1e-6f) * (isq ? QSCALE_GQA : 1.0f);
        const int n = row & (S - 1); const float pos = (float)(axis == 0 ? (n >> 6) : (n & 63));
        float o1[8], o2[8];
#pragma unroll
        for (int e = 0; e < 8; ++e) {
            const int f = fg * 8 + e; const float inv = __builtin_amdgcn_exp2f(-(float)f * 0.8304820237218406f);
            const float rev = pos * inv * 0.15915494309189535f; const float c = __builtin_amdgcn_cosf(rev), s = __builtin_amdgcn_sinf(rev);
            const float a = x1[e] * rs * nw[axis * 32 + f], b = x2[e] * rs * nw[axis * 32 + 16 + f];
            o1[e] = a * c - b * s; o2[e] = b * c + a * s;
        }
        u32x4 r1, r2;
#pragma unroll
        for (int e = 0; e < 4; ++e) { r1[e] = cvt_pk_bf16(o1[2 * e], o1[2 * e + 1]); r2[e] = cvt_pk_bf16(o2[2 * e], o2[2 * e + 1]); }
        *(u32x4*)p1 = r1; *(u32x4*)p2 = r2;
    }
}

__device__ __forceinline__ void phase_dnprep(const Params& p, int l, int S, int lgS, int B, LAS unsigned char* lds) {
    unsigned char* const ws_ = ows(p);
    const int tid = otid(), lane = tid & 63, wid = __builtin_amdgcn_readfirstlane(tid >> 6), r32 = lane & 31, hi = lane >> 5;
    LAS float* qf = (LAS float*)lds; LAS float* kf = qf + 64 * 65; LAS float* vf = kf + 64 * 65; LAS float* G = vf + 64 * 65; LAS float* QK = G + 64 * 65;
    LAS float* Lm = QK + 64 * 65; LAS bf16_t* qh = (LAS bf16_t*)(Lm + 2 * 4096); LAS bf16_t* kh = qh + 64 * 72;
    LAS float* gs = (LAS float*)(kh + 64 * 72); LAS float* bs = gs + 128; LAS float* gc = bs + 128;
    const bf16_t* Z = (const bf16_t*)(ws_ + WS_BIG + BG_Z); const float* AB = (const float*)(ws_ + WS_AB);
    bf16_t* DN = (bf16_t*)(ws_ + WS_DN); float* GL = (float*)(ws_ + WS_GL);
    const float* conv = p.in[10] + (size_t)l * 3 * 768; const float* Alog = p.in[11] + l * 8; const float* dtb = p.in[12] + l * 8;
    const int Nc = S >> 6; const int nunits = NTOK / 64 * 4;
    for (int unit = obid(); unit < nunits; unit += gridDim.x) {
        const int h = unit & 3, gq = unit >> 4, gsub = (unit >> 2) & 3; const int gch = ((32 * ((gq >> 3) & 7) + 8 * (3 - (gq >> 6)) + (gq & 7)) << 2) + gsub;
        const int b = gch >> (lgS - 6), n = gch & (Nc - 1), tok0 = gch * 64;
        {
            const int t = tid >> 3, s8 = tid & 7, row = tok0 + t, npos = n * 64 + t;
            const bf16_t* zr = Z + (size_t)row * 2048 + 768 + h * 64 + s8 * 8;
            float aq[8], ak[8], av[8];
#pragma unroll
            for (int e = 0; e < 8; ++e) { aq[e] = 0.f; ak[e] = 0.f; av[e] = 0.f; }
#pragma unroll
            for (int tap = 0; tap < 3; ++tap) {
                const int pp = npos + tap - 1;
                if (pp >= 0 && pp < S) {
                    const bf16_t* zz = zr + (tap - 1) * 2048; const u32x4 wq_ = *(const u32x4*)zz, wk_ = *(const u32x4*)(zz + 256), wv_ = *(const u32x4*)(zz + 512);
                    const float* cw = conv + tap * 768 + h * 64 + s8 * 8;
                    const f32x4 cq0 = *(const f32x4*)cw, cq1 = *(const f32x4*)(cw + 4), ck0 = *(const f32x4*)(cw + 256), ck1 = *(const f32x4*)(cw + 260), cv0 = *(const f32x4*)(cw + 512), cv1 = *(const f32x4*)(cw + 516);
#pragma unroll
                    for (int e = 0; e < 4; ++e) {
                        const float wq0 = e < 2 ? cq0[2 * e] : cq1[2 * e - 4], wq1 = e < 2 ? cq0[2 * e + 1] : cq1[2 * e - 3];
                        const float wk0 = e < 2 ? ck0[2 * e] : ck1[2 * e - 4], wk1 = e < 2 ? ck0[2 * e + 1] : ck1[2 * e - 3];
                        const float wv0 = e < 2 ? cv0[2 * e] : cv1[2 * e - 4], wv1 = e < 2 ? cv0[2 * e + 1] : cv1[2 * e - 3];
                        aq[2 * e] += bflo(wq_[e]) * wq0; aq[2 * e + 1] += bfhi(wq_[e]) * wq1;
                        ak[2 * e] += bflo(wk_[e]) * wk0; ak[2 * e + 1] += bfhi(wk_[e]) * wk1;
                        av[2 * e] += bflo(wv_[e]) * wv0; av[2 * e + 1] += bfhi(wv_[e]) * wv1;
                    }
                }
            }
            float sq = 0.f, sk = 0.f;
#pragma unroll
            for (int e = 0; e < 8; ++e) { aq[e] = aq[e] * __builtin_amdgcn_rcpf(1.0f + __expf(-aq[e])); ak[e] = ak[e] * __builtin_amdgcn_rcpf(1.0f + __expf(-ak[e])); av[e] = av[e] * __builtin_amdgcn_rcpf(1.0f + __expf(-av[e]));
                sq += aq[e] * aq[e]; sk += ak[e] * ak[e]; }
            sq += shx(sq, 1, lane); sq += shx(sq, 2, lane); sq += shx(sq, 4, lane);
            sk += shx(sk, 1, lane); sk += shx(sk, 2, lane); sk += shx(sk, 4, lane);
            const float rq = rsqrtf(sq + 1e-6f) * 0.125f, rk = rsqrtf(sk + 1e-6f);
#pragma unroll
            for (int e = 0; e < 8; ++e) { aq[e] *= rq; ak[e] *= rk; qf[t * 65 + s8 * 8 + e] = aq[e]; kf[t * 65 + s8 * 8 + e] = ak[e]; vf[t * 65 + s8 * 8 + e] = av[e]; }
            *(LAS bf16x8*)(qh + t * 72 + s8 * 8) = pack8(aq[0], aq[1], aq[2], aq[3], aq[4], aq[5], aq[6], aq[7]);
            *(LAS bf16x8*)(kh + t * 72 + s8 * 8) = pack8(ak[0], ak[1], ak[2], ak[3], ak[4], ak[5], ak[6], ak[7]);
            if (s8 < 2) {
                const int dir = s8; const float a = AB[(size_t)row * 16 + dir * 4 + h], bb = AB[(size_t)row * 16 + 8 + dir * 4 + h];
                const float xx = a + dtb[dir * 4 + h]; const float sp = xx > 20.f ? xx : log1pf(expf(xx));
                gs[dir * 64 + t] = -expf(Alog[dir * 4 + h]) * sp; bs[dir * 64 + t] = 1.0f / (1.0f + expf(-bb));
            }
        }
        __syncthreads();
        {
            const int mat = wid >> 2, ti = (wid >> 1) & 1, tj = wid & 1; const LAS bf16_t* am = mat ? qh : kh;
            f32x16 acc = {0.f, 0.f, 0.f, 0.f, 0.f, 0.f, 0.f, 0.f, 0.f, 0.f, 0.f, 0.f, 0.f, 0.f, 0.f, 0.f};
#pragma unroll
            for (int d0 = 0; d0 < 4; ++d0) { const bf16x8 a = *(const LAS bf16x8*)(am + (32 * ti + r32) * 72 + 16 * d0 + 8 * hi), bq = *(const LAS bf16x8*)(kh + (32 * tj + r32) * 72 + 16 * d0 + 8 * hi);
                acc = __builtin_amdgcn_mfma_f32_32x32x16_bf16(a, bq, acc, 0, 0, 0); }
            LAS float* M = mat ? QK : G;
#pragma unroll
            for (int r = 0; r < 16; ++r) M[(32 * ti + crow(r, hi)) * 65 + 32 * tj + r32] = acc[r];
            if (wid < 2) { const int dir = wid; float v = gs[dir * 64 + (dir ? 63 - lane : lane)];
#pragma unroll
                for (int o = 1; o < 64; o <<= 1) { const float tt = __int_as_float(__builtin_amdgcn_ds_bpermute(((lane - o) & 63) << 2, __float_as_int(v))); if (lane >= o) v += tt; }
                gc[dir * 64 + lane] = v; }
        }
        __syncthreads();
        const int m0 = n, m1 = Nc - 1 - n;
        bf16_t* dn0 = DN + ((((size_t)(b * 4 + h) * 2 + 0) * Nc + m0) * 20480); bf16_t* dn1 = DN + ((((size_t)(b * 4 + h) * 2 + 1) * Nc + m1) * 20480);
        {
            const int dir = tid >> 8, i = (tid >> 2) & 63, jq = tid & 3, ti_ = dir ? 63 - i : i; const float gci = gc[dir * 64 + i], bi = bs[dir * 64 + ti_];
            float qv[16];
#pragma unroll
            for (int e = 0; e < 16; ++e) { const int j = jq * 16 + e, tj_ = dir ? 63 - j : j; const float dec = (j <= i) ? __expf(gci - gc[dir * 64 + j]) : 0.f;
                Lm[dir * 4096 + i * 64 + j] = (j < i) ? bi * G[ti_ * 65 + tj_] * dec : 0.f; qv[pos16(e)] = QK[ti_ * 65 + tj_] * dec; }
            bf16_t* dst = (dir ? dn1 : dn0) + 2 * 4096 + i * 64 + jq * 16;
            *(bf16x8*)dst = pack8(qv[0], qv[1], qv[2], qv[3], qv[4], qv[5], qv[6], qv[7]); *(bf16x8*)(dst + 8) = pack8(qv[8], qv[9], qv[10], qv[11], qv[12], qv[13], qv[14], qv[15]);
        }
        __syncthreads();
        if (wid < 4) {
            const int dir = wid >> 1, half = wid & 1; const LAS float* src = half ? kf : vf; const LAS float* L = Lm + dir * 4096;
            float x[64]; const int rb_ = dir ? 63 : 0, rs_ = dir ? -1 : 1;
#pragma unroll
            for (int i = 0; i < 64; ++i) { const int ti_ = rb_ + rs_ * i; const float r = src[ti_ * 65 + lane] * bs[dir * 64 + ti_]; const float e = __expf(gc[dir * 64 + i]); x[i] = half ? r * e : r; }
#pragma unroll
            for (int i = 1; i < 64; ++i) { float s0 = x[i], s1 = 0.f, s2 = 0.f, s3 = 0.f; const LAS f32x4* Lr = (const LAS f32x4*)(L + i * 64);
#pragma unroll
                for (int j4 = 0; j4 < (i + 3) / 4; ++j4) { const f32x4 lv = Lr[j4]; s0 -= lv[0] * x[4 * j4]; s1 -= lv[1] * x[4 * j4 + 1]; s2 -= lv[2] * x[4 * j4 + 2]; s3 -= lv[3] * x[4 * j4 + 3]; }
                x[i] = (s0 + s1) + (s2 + s3); }
            bf16_t* dn = dir ? dn1 : dn0;
            if (half == 0) {
                const int ch = lane >> 5, nn = lane & 31;
#pragma unroll
                for (int T = 0; T < 2; ++T)
#pragma unroll
                    for (int hh = 0; hh < 2; ++hh) { bf16_t* d = dn + 4 * 4096 + ((ch * 2 + T) * 64 + hh * 32 + nn) * 16;
#define XR(r) x[32 * T + ((r) & 3) + 8 * ((r) >> 2) + 4 * hh]
                        *(bf16x8*)d = pack8(XR(0), XR(1), XR(2), XR(3), XR(4), XR(5), XR(6), XR(7)); *(bf16x8*)(d + 8) = pack8(XR(8), XR(9), XR(10), XR(11), XR(12), XR(13), XR(14), XR(15));
#undef XR
                    }
            } else {
                const int pc = (lane & ~15) + pos16(lane & 15);
#pragma unroll
                for (int i = 0; i < 64; ++i) dn[i * 64 + pc] = f2bf(-x[i]);
            }
        } else {
            const int dir = (wid >> 1) & 1, which = wid & 1; bf16_t* dn = dir ? dn1 : dn0;
            if (which == 0) { const int pc = (lane & ~15) + pos16(lane & 15);
#pragma unroll 8
                for (int i = 0; i < 64; ++i) { const int ti_ = dir ? 63 - i : i; dn[4096 + i * 64 + pc] = f2bf(qf[ti_ * 65 + lane] * __expf(gc[dir * 64 + i])); }
            } else { const int i = (lane & ~15) + pos16(lane & 15); const int ti_ = dir ? 63 - i : i; const float glast = gc[dir * 64 + 63]; const float sc = __expf(glast - gc[dir * 64 + i]);
#pragma unroll 8
                for (int d = 0; d < 64; ++d) dn[3 * 4096 + d * 64 + lane] = f2bf(kf[ti_ * 65 + d] * sc);
                if (lane == 0) GL[((size_t)(b * 4 + h) * 2 + dir) * Nc + (dir ? m1 : m0)] = __expf(glast); }
        }
        __syncthreads();
    }
}

__device__ __forceinline__ void phase_dnscan(const Params& p, int S, int lgS, int B) {
    unsigned char* const ws_ = ows(p);
    const int tid = otid(), lane = tid & 63, wid = __builtin_amdgcn_readfirstlane(tid >> 6), r32 = lane & 31, hi = lane >> 5;
    const int wk = wid * gridDim.x + obid(); if (wk >= B * 16) return;
    const int half = wk & 1, dir = (wk >> 1) & 1, h = (wk >> 2) & 3, b = wk >> 4; const int Nc = S >> 6;
    const bf16_t* DN = (const bf16_t*)(ws_ + WS_DN) + ((size_t)(b * 4 + h) * 2 + dir) * Nc * 20480; const float* GL = (const float*)(ws_ + WS_GL) + ((size_t)(b * 4 + h) * 2 + dir) * Nc;
    float* O2 = (float*)(ws_ + WS_X1) + (size_t)dir * NTOK * 256;
    f32x16 s0 = {0.f, 0.f, 0.f, 0.f, 0.f, 0.f, 0.f, 0.f, 0.f, 0.f, 0.f, 0.f, 0.f, 0.f, 0.f, 0.f}, s1 = s0;
    const f32x16 zero16 = s0;
    for (int m = 0; m < Nc; ++m) {
        const bf16_t* base = DN + (size_t)m * 20480; const float eg = GL[m];
        bf16x8 aw[2][4], aqd[2][4], aqk[2][4], akt[2][4]; u32x4 uu[2][2];
#pragma unroll
        for (int T = 0; T < 2; ++T) {
            const u32x4* up = (const u32x4*)(base + 4 * 4096 + ((half * 2 + T) * 64 + lane) * 16); uu[T][0] = up[0]; uu[T][1] = up[1];
#pragma unroll
            for (int kk = 0; kk < 4; ++kk) aw[T][kk] = *(const bf16x8*)(base + (32 * T + r32) * 64 + 16 * kk + 8 * hi);
        }
#pragma unroll
        for (int T = 0; T < 2; ++T)
#pragma unroll
            for (int kk = 0; kk < 4; ++kk) { aqd[T][kk] = *(const bf16x8*)(base + 4096 + (32 * T + r32) * 64 + 16 * kk + 8 * hi); aqk[T][kk] = *(const bf16x8*)(base + 2 * 4096 + (32 * T + r32) * 64 + 16 * kk + 8 * hi);
                akt[T][kk] = *(const bf16x8*)(base + 3 * 4096 + (32 * T + r32) * 64 + 16 * kk + 8 * hi); }
        asm volatile("" ::: "memory");
        bf16x8 sb[4];
        sb[0] = pack8(s0[0], s0[1], s0[2], s0[3], s0[4], s0[5], s0[6], s0[7]); sb[1] = pack8(s0[8], s0[9], s0[10], s0[11], s0[12], s0[13], s0[14], s0[15]);
        sb[2] = pack8(s1[0], s1[1], s1[2], s1[3], s1[4], s1[5], s1[6], s1[7]); sb[3] = pack8(s1[8], s1[9], s1[10], s1[11], s1[12], s1[13], s1[14], s1[15]);
        f32x16 vn[2];
#pragma unroll
        for (int T = 0; T < 2; ++T) {
            f32x16 c;
#pragma unroll
            for (int e = 0; e < 4; ++e) { c[2 * e] = bflo(uu[T][0][e]); c[2 * e + 1] = bfhi(uu[T][0][e]); c[8 + 2 * e] = bflo(uu[T][1][e]); c[9 + 2 * e] = bfhi(uu[T][1][e]); }
#pragma unroll
            for (int kk = 0; kk < 4; ++kk) c = __builtin_amdgcn_mfma_f32_32x32x16_bf16(aw[T][kk], sb[kk], c, 0, 0, 0);
            vn[T] = c;
        }
        bf16x8 vb[4];
        vb[0] = pack8(vn[0][0], vn[0][1], vn[0][2], vn[0][3], vn[0][4], vn[0][5], vn[0][6], vn[0][7]); vb[1] = pack8(vn[0][8], vn[0][9], vn[0][10], vn[0][11], vn[0][12], vn[0][13], vn[0][14], vn[0][15]);
        vb[2] = pack8(vn[1][0], vn[1][1], vn[1][2], vn[1][3], vn[1][4], vn[1][5], vn[1][6], vn[1][7]); vb[3] = pack8(vn[1][8], vn[1][9], vn[1][10], vn[1][11], vn[1][12], vn[1][13], vn[1][14], vn[1][15]);
        const int nchunk = dir ? Nc - 1 - m : m;
        int hi_ = hi; asm volatile("" : "+v"(hi_));
        float* orow = O2 + ((size_t)(b * S + nchunk * 64) * 256 + h * 64 + half * 32 + r32); const int rstep = dir ? -256 : 256; if (dir) orow += 63 * 256;
#pragma unroll
        for (int T = 0; T < 2; ++T) {
            f32x16 o = zero16;
#pragma unroll
            for (int kk = 0; kk < 4; ++kk) o = __builtin_amdgcn_mfma_f32_32x32x16_bf16(aqd[T][kk], sb[kk], o, 0, 0, 0);
#pragma unroll
            for (int kk = 0; kk < 4; ++kk) o = __builtin_amdgcn_mfma_f32_32x32x16_bf16(aqk[T][kk], vb[kk], o, 0, 0, 0);
#pragma unroll
            for (int r = 0; r < 16; ++r) { const int i = 32 * T + crow(r, hi_); orow[i * rstep] = o[r]; }
        }
        s0 = s0 * eg; s1 = s1 * eg;
#pragma unroll
        for (int kk = 0; kk < 4; ++kk) { s0 = __builtin_amdgcn_mfma_f32_32x32x16_bf16(akt[0][kk], vb[kk], s0, 0, 0, 0); s1 = __builtin_amdgcn_mfma_f32_32x32x16_bf16(akt[1][kk], vb[kk], s1, 0, 0, 0); }
    }
}

__device__ __forceinline__ void phase_dncombine(const Params& p, int l) {
    unsigned char* const ws_ = ows(p);
    const float* O2 = (const float*)(ws_ + WS_X1); const bf16_t* Z = (const bf16_t*)(ws_ + WS_BIG + BG_Z); bf16_t* YC = (bf16_t*)(ws_ + WS_YC); const float* on = p.in[13] + l * 64;
    const int total = NTOK * 32; const int tid = otid(), lane = tid & 63;
    for (int i = obid() * 512 + tid; i < total; i += gridDim.x * 512) {
        const int row = i >> 5, c0 = (i & 31) * 8;
        const f32x4 a0 = *(const f32x4*)(O2 + (size_t)row * 256 + c0), a1 = *(const f32x4*)(O2 + (size_t)row * 256 + c0 + 4);
        const f32x4 b0 = *(const f32x4*)(O2 + (size_t)(NTOK + row) * 256 + c0), b1 = *(const f32x4*)(O2 + (size_t)(NTOK + row) * 256 + c0 + 4);
        float o[8] = {a0[0] + b0[0], a0[1] + b0[1], a0[2] + b0[2], a0[3] + b0[3], a1[0] + b1[0], a1[1] + b1[1], a1[2] + b1[2], a1[3] + b1[3]};
        float ss = 0.f;
#pragma unroll
        for (int e = 0; e < 8; ++e) ss += o[e] * o[e];
        ss += shx(ss, 1, lane); ss += shx(ss, 2, lane); ss += shx(ss, 4, lane);
        const float rs = rsqrtf(ss * (1.0f / 64.0f) + 1e-6f);
        const u32x4 gw = *(const u32x4*)(Z + (size_t)row * 2048 + 1536 + c0);
        float r[8];
#pragma unroll
        for (int e = 0; e < 8; ++e) { const float g = (e & 1) ? bfhi(gw[e >> 1]) : bflo(gw[e >> 1]); r[e] = o[e] * rs * on[(c0 & 63) + e] * g * __builtin_amdgcn_rcpf(1.0f + __expf(-g)); }
        *(bf16x8*)(YC + (size_t)row * 1024 + 256 + c0) = pack8(r[0], r[1], r[2], r[3], r[4], r[5], r[6], r[7]);
    }
}

__device__ __forceinline__ void phase_attn(const Params& p, int S, int lgS, int B, int* counter, LAS unsigned char* lds) {
    unsigned char* const ws_ = ows(p);
    const int tid = otid(), lane = tid & 63, wid = __builtin_amdgcn_readfirstlane(tid >> 6), r32 = lane & 31, hi = lane >> 5;
    const bf16_t* Z = (const bf16_t*)(ws_ + WS_BIG + BG_Z); const bf16_t* VT = (const bf16_t*)(ws_ + WS_BIG + BG_VT); bf16_t* YC = (bf16_t*)(ws_ + WS_YC);
    constexpr int KB = 128 * 72 * 2, BUFB = KB + 64 * 136 * 2;
    const int nqt = S >> 8, lgq = lgS - 8, nunits = B * 8 * nqt, NT = S >> 7;
    LAS float* wsf = (LAS float*)(lds + 2 * BUFB + wid * 256);
    const int skey = tid >> 3, spc = tid & 7;
    const int kdst = (skey * 72 + spc * 8) * 2, vdst = KB + (skey * 136 + spc * 8) * 2;
    const int klane = (r32 * 72 + 8 * hi) * 2, vlane = (r32 * 136 + 4 * hi) * 2;
    const int G_ = (int)gridDim.x, bid_ = obid(), nscan = B * 16, per = nunits / G_;
    const bool deal = (nunits % G_ == 0) && (2 * nscan <= G_) && (per >= 2);
    const int nmine = !deal ? ((bid_ < nunits) ? (nunits - bid_ + G_ - 1) / G_ : 0) : (bid_ < nscan ? per - 1 : (bid_ < 2 * nscan ? per + 1 : per));
    for (int ui = 0; ui < nmine; ++ui) {
        const int unit = (deal && ui == per) ? (bid_ - nscan) + G_ * (per - 1) : bid_ + ui * G_;
        const int hq4 = unit & 3, qt = (unit >> 2) & (nqt - 1), bk = unit >> (2 + lgq), kvh = bk & 1, b = bk >> 1, qh = kvh * 4 + hq4;
        const size_t rowq = (size_t)b * S + qt * 256 + wid * 32 + r32;
        bf16x8 qr[4];
#pragma unroll
        for (int d0 = 0; d0 < 4; ++d0) qr[d0] = *(const bf16x8*)(Z + rowq * 2048 + qh * 64 + d0 * 16 + hi * 8);
        const bf16_t* ksrc = Z + ((size_t)b * S + skey) * 2048 + 512 + kvh * 64 + spc * 8;
        const bf16_t* vsrc = VT + (((size_t)(b * 128 + kvh * 64 + skey)) << lgS) + spc * 8;
        u32x4 kreg0 = *(const u32x4*)ksrc, kreg1 = *(const u32x4*)(ksrc + (size_t)64 * 2048), vreg0 = *(const u32x4*)vsrc, vreg1 = *(const u32x4*)(vsrc + 64);
        *(LAS u32x4*)(lds + kdst) = kreg0; *(LAS u32x4*)(lds + kdst + 64 * 144) = kreg1; *(LAS u32x4*)(lds + vdst) = vreg0; *(LAS u32x4*)(lds + vdst + 128) = vreg1;
        __syncthreads();
        float m_run = 0.f, l_run = 0.f;
        f32x16 o0 = {0.f, 0.f, 0.f, 0.f, 0.f, 0.f, 0.f, 0.f, 0.f, 0.f, 0.f, 0.f, 0.f, 0.f, 0.f, 0.f}, o1 = o0; const f32x16 zero16 = o0; f32x16 negm = o0;
        for (int t = 0; t < NT; ++t) {
            const LAS unsigned char* kb = lds + (t & 1) * BUFB; const LAS unsigned char* vb = kb + KB;
            if (t + 1 < NT) { const bf16_t* kn = ksrc + (size_t)(t + 1) * 128 * 2048; const bf16_t* vn_ = vsrc + (t + 1) * 128;
                kreg0 = *(const u32x4*)kn; kreg1 = *(const u32x4*)(kn + (size_t)64 * 2048); vreg0 = *(const u32x4*)vn_; vreg1 = *(const u32x4*)(vn_ + 64); }
            f32x16 pp[4] = {negm, negm, negm, negm};
            const LAS unsigned char* kl = kb + klane; const LAS unsigned char* vl = vb + vlane;
#pragma unroll
            for (int d0 = 0; d0 < 4; ++d0)
#pragma unroll
                for (int j = 0; j < 4; ++j) { const bf16x8 a = *(const LAS bf16x8*)(kl + (32 * j * 72 + 16 * d0) * 2); pp[j] = __builtin_amdgcn_mfma_f32_32x32x16_bf16(a, qr[d0], pp[j], 0, 0, 0); }
            float mxa = fmaxf(pp[0][0], pp[1][0]), mxb = fmaxf(pp[2][0], pp[3][0]);
#pragma unroll
            for (int r = 1; r < 16; ++r) { mxa = fmaxf(fmaxf(mxa, pp[0][r]), pp[1][r]); mxb = fmaxf(fmaxf(mxb, pp[2][r]), pp[3][r]); }
            float mx = fmaxf(mxa, mxb);
            mx = fmaxf(mx, shx(mx, 32, lane));
            const bool first = (t == 0);
            if (first || __any(mx > 8.f)) {
                const float d = first ? mx : fmaxf(mx, 0.f);
                m_run += d;
#pragma unroll
                for (int j = 0; j < 4; ++j)
#pragma unroll
                    for (int r = 0; r < 16; ++r) pp[j][r] -= d;
#pragma unroll
                for (int r = 0; r < 16; ++r) negm[r] = -m_run;
                if (!first) {
                    const float alpha = __builtin_amdgcn_exp2f(-d); l_run *= alpha;
                    if (hi == 0) wsf[r32] = alpha;
                    LDS_WAIT();
#pragma unroll
                    for (int r = 0; r < 16; ++r) { const float f = wsf[crow(r, hi)]; o0[r] *= f; o1[r] *= f; }
                    LDS_WAIT();
                }
            }
            float ls = 0.f;
#pragma unroll
            for (int j = 0; j < 4; ++j)
#pragma unroll
                for (int r = 0; r < 16; ++r) { pp[j][r] = __builtin_amdgcn_exp2f(pp[j][r]); ls += pp[j][r]; }
            l_run += ls;
#pragma unroll
            for (int j = 0; j < 4; ++j)
#pragma unroll
                for (int kk = 0; kk < 2; ++kk) {
                    const int ks = 2 * j + kk;
                    const bf16x8 pa = pack8(pp[j][8 * kk], pp[j][8 * kk + 1], pp[j][8 * kk + 2], pp[j][8 * kk + 3], pp[j][8 * kk + 4], pp[j][8 * kk + 5], pp[j][8 * kk + 6], pp[j][8 * kk + 7]);
                    const u32x2 v0a = *(const LAS u32x2*)(vl + (16 * ks) * 2), v0b = *(const LAS u32x2*)(vl + (16 * ks + 8) * 2);
                    const u32x2 v1a = *(const LAS u32x2*)(vl + (32 * 136 + 16 * ks) * 2), v1b = *(const LAS u32x2*)(vl + (32 * 136 + 16 * ks + 8) * 2);
                    const u32x4 f0 = {v0a.x, v0a.y, v0b.x, v0b.y}, f1 = {v1a.x, v1a.y, v1b.x, v1b.y};
                    o0 = __builtin_amdgcn_mfma_f32_32x32x16_bf16(pa, __builtin_bit_cast(bf16x8, f0), o0, 0, 0, 0);
                    o1 = __builtin_amdgcn_mfma_f32_32x32x16_bf16(pa, __builtin_bit_cast(bf16x8, f1), o1, 0, 0, 0);
                }
            if (t + 1 < NT) { LAS unsigned char* nb = lds + ((t + 1) & 1) * BUFB;
                *(LAS u32x4*)(nb + kdst) = kreg0; *(LAS u32x4*)(nb + kdst + 64 * 144) = kreg1; *(LAS u32x4*)(nb + vdst) = vreg0; *(LAS u32x4*)(nb + vdst + 128) = vreg1; }
            __syncthreads();
        }
        l_run += shx(l_run, 32, lane);
        if (hi == 0) wsf[32 + r32] = l_run;
        LDS_WAIT();
        bf16_t* orow = YC + ((size_t)b * S + qt * 256 + wid * 32) * 1024 + 512 + qh * 64;
#pragma unroll
        for (int r = 0; r < 16; ++r) { const int q = crow(r, hi); const float inv = 1.0f / wsf[32 + q];
            orow[(size_t)q * 1024 + r32] = f2bf(o0[r] * inv); orow[(size_t)q * 1024 + 32 + r32] = f2bf(o1[r] * inv); }
        LDS_WAIT();
    }
}

__device__ __forceinline__ void phase_final(const Params& p, float* X) {
    unsigned char* const ws_ = ows(p);
    const int tid = otid(), lane = tid & 63, wid = tid >> 6; const int gw = obid() * 8 + wid, NGW = gridDim.x * 8;
    const float* ssq = (const float*)(ws_ + WS_SSQ); const f32x4* fw = (const f32x4*)p.in[25] + lane;
    f32x4 w[4];
#pragma unroll
    for (int j = 0; j < 4; ++j) w[j] = fw[64 * j];
    for (int row = gw; row < NTOK; row += NGW) {
        const float rs = row_rstd(ssq, row); f32x4* xr = (f32x4*)(X + (size_t)row * 1024) + lane;
#pragma unroll
        for (int j = 0; j < 4; ++j) { const f32x4 v = xr[64 * j]; xr[64 * j] = v * rs * w[j]; }
    }
}

#define XB_TMO      128
#define XB_XCNT(j)  (256  + 64 * (j))
#define XB_XSUB(j)  (1280 + 64 * (j))
#define XB_XGEN(j)  (2304 + 64 * (j))
#define XB_TOP      3328
#define XB_TOPGEN   3392
#define XCD_BAR_WORDS 3456
#define XB_SPIN_CAP (1u << 22)
__device__ __forceinline__ unsigned xb_ld(unsigned* p)              { return __hip_atomic_load(p, __ATOMIC_RELAXED, __HIP_MEMORY_SCOPE_AGENT); }
__device__ __forceinline__ unsigned xb_add(unsigned* p, unsigned v) { return __hip_atomic_fetch_add(p, v, __ATOMIC_RELAXED, __HIP_MEMORY_SCOPE_AGENT); }
__device__ __forceinline__ unsigned xb_xcc_id() { return (unsigned)__builtin_amdgcn_s_getreg((3 << 11) | 20) & 0xFu; }
#define XB_SPIN(cond, bar) do { unsigned _sp = 0; while (cond) { __builtin_amdgcn_s_sleep(1); \
    if ((++_sp & 255u) == 0u) { if (xb_ld(&(bar)[XB_TMO])) break; if (_sp > XB_SPIN_CAP) { atomicAdd(&(bar)[XB_TMO], 1u); break; } } } } while (0)
__device__ __forceinline__ void xcd_barrier_complete(unsigned* bar, unsigned x, unsigned& nloc, unsigned& nx) {
    const unsigned G = gridDim.x * gridDim.y * gridDim.z;
    unsigned sum, cnt, mine, sp = 0u;
    for (;;) {
        sum = 0u; cnt = 0u; mine = 0u;
#pragma unroll
        for (unsigned j = 0; j < 16; ++j) { const unsigned c = xb_ld(&bar[XB_XCNT(j)]); sum += c; cnt += (c > 0u) ? 1u : 0u; mine = (j == x) ? c : mine; }
        if (sum == G) break;
        __builtin_amdgcn_s_sleep(1);
        if ((++sp & 255u) == 0u) { if (xb_ld(&bar[XB_TMO])) break; if (sp > XB_SPIN_CAP) { atomicAdd(&bar[XB_TMO], 1u); break; } }
    }
    nloc = mine > 0u ? mine : 1u; nx = cnt > 0u ? cnt : 1u;
}
__device__ __forceinline__ void xcd_barrier(unsigned* bar, volatile LAS unsigned* st) {
    asm volatile("s_waitcnt vmcnt(0) lgkmcnt(0)" ::: "memory");
    __syncthreads();
    if (threadIdx.x == 0) {
        __builtin_amdgcn_s_waitcnt(0);
        const unsigned x = xb_xcc_id();
        unsigned nloc = st[0], nx = st[1];
        if (nloc == 0u) { xcd_barrier_complete(bar, x, nloc, nx); st[0] = nloc; st[1] = nx; }
        const unsigned old = xb_add(&bar[XB_XSUB(x)], 1u);
        const unsigned gen = old / nloc;
        if (old + 1u == (gen + 1u) * nloc) {
            __builtin_amdgcn_fence(__ATOMIC_RELEASE, "agent");
            asm volatile("s_waitcnt vmcnt(0)" ::: "memory");
            const unsigned og = xb_add(&bar[XB_TOP], 1u);
            const unsigned tg = og / nx;
            if (og + 1u == (tg + 1u) * nx) xb_add(&bar[XB_TOPGEN], 1u);
            else XB_SPIN(xb_ld(&bar[XB_TOPGEN]) == tg, bar);
            __builtin_amdgcn_fence(__ATOMIC_ACQUIRE, "agent");
            xb_add(&bar[XB_XGEN(x)], 1u);
            asm volatile("s_waitcnt vmcnt(0)" ::: "memory");
        } else {
            XB_SPIN(xb_ld(&bar[XB_XGEN(x)]) == gen, bar);
            __builtin_amdgcn_fence(__ATOMIC_ACQUIRE, "agent");
            asm volatile("s_waitcnt vmcnt(0)" ::: "memory");
        }
    }
    __syncthreads();
}
#define GRID_SYNC() xcd_barrier((unsigned*)(p.ws + WS_CNT + 4096), (volatile LAS unsigned*)(lds + XB_LDS_OFF))
__global__ void __launch_bounds__(512, 2) mega_fwd(Params p) {
    extern __shared__ __attribute__((aligned(16))) unsigned char lds_raw[];
    LAS unsigned char* lds = (LAS unsigned char*)lds_raw;
    cg::grid_group grid = cg::this_grid();
    if (threadIdx.x < 4) ((LAS unsigned*)(lds + XB_LDS_OFF))[threadIdx.x] = 0u;
    __syncthreads();
    if (threadIdx.x == 0) (void)xb_add((unsigned*)(p.ws + WS_CNT + 4096) + XB_XCNT(xb_xcc_id()), 1u);
    grid.sync();
#ifdef PROBE_ZERO
    {
        u32x4* z = (u32x4*)p.ws; const size_t n = WS_END / 16; const u32x4 zz = {0u, 0u, 0u, 0u};
        for (size_t i = (size_t)blockIdx.x * 512 + threadIdx.x; i < n; i += (size_t)gridDim.x * 512) { if (i < WS_CNT / 16 || i >= (WS_CNT + 4096) / 16) z[i] = zz; }
        GRID_SYNC();
    }
#endif
    const int G = gridDim.x;
#define KW_PTRS unsigned char* const ws = ows(p); const int cid = obid(); bf16_t* const W = (bf16_t*)(ws + WS_W); bf16_t* const X1 = (bf16_t*)(ws + WS_X1); bf16_t* const YC = (bf16_t*)(ws + WS_YC); unsigned char* const BIG = ws + WS_BIG; \
    float* const ssq = (float*)(ws + WS_SSQ); const float* const mssq = (const float*)(ws + WS_MSSQ); (void)W; (void)X1; (void)YC; (void)BIG; (void)ssq; (void)mssq; (void)cid;
    for (int pass = 0; pass < 2; ++pass) {
        const int grp = 1 - pass; const int S = grp ? 8192 : 2048, lgS = grp ? 13 : 11, B = grp ? 8 : 32;
        float* X = p.out + (grp ? (size_t)67108864 : (size_t)0);
        bf16_t* DFT = grp ? (bf16_t*)p.out : (bf16_t*)(p.ws + WS_DFT2);
        if (PH(0)) phase_init(p, grp, S, lgS, B, X, DFT);
        for (int l = 0; l < 2; ++l) {
            if (l == 0) { if (PH(1)) { phase_pq(p, 0); phase_pq(p, 1); } GRID_SYNC(); }
            if (PH(2)) phase_weights(p, l, lds);
            GRID_SYNC();
            for (int rep = 0; rep < REP_SYNC; ++rep) { GRID_SYNC(); }
            for (int f = 0; f < 2; ++f) {
                if (f == 1) {
                    if (EN_MIX && PH(3)) { KW_PTRS pg8::Gemm g{X1, W + W_IN, 1024, 1024, 1024}; pg8::StaticOrder so; so.init(256, 10, G, cid);
                      pg8::EpiWin E{(bf16_t*)(BIG + BG_Z), (bf16_t*)(BIG + BG_FT), (bf16_t*)(BIG + BG_VT), (float*)(ws + WS_AB), ssq, S, lgS};
                      pg8::gemm_phase(lds, g, so, pg8::AddrStd{}, E); }
                    GRID_SYNC();
                    if (EN_MIX && EN_DFT && PH(8)) phase_fold(p, S, lgS, B, lds);
                    if (EN_MIX && EN_ATT && PH(4)) phase_qkrope(p, l, S, lgS);
                    for (int rep = 0; rep < REP_PREP; ++rep) { if (EN_MIX && EN_DN && PH(5)) phase_dnprep(p, l, S, lgS, B, lds); }
                    GRID_SYNC();
                    for (int rep = 0; rep < REP_SCAN; ++rep) { if (EN_MIX && EN_DN && PH(6)) phase_dnscan(p, S, lgS, B); }
                    __syncthreads();
                    for (int rep = 0; rep < REP_ATT; ++rep) { if (EN_MIX && EN_ATT && PH(7)) phase_attn(p, S, lgS, B, (int*)(p.ws + WS_CNT) + (pass * 2 + l) * 64, lds); __syncthreads(); }
                    if (EN_MIX && EN_DFT && PH(8)) { KW_PTRS pg8::Gemm g{DFT, (const bf16_t*)(BIG + BG_FT), S, S, 2 * S}; pg8::StaticOrder so; so.init(S >> 8, B, G, cid);
                      pg8::EpiBf16<2> E{YC, 1024, nullptr, rsqrtf((float)S * 64.0f), S};
                      pg8::gemm_phase(lds, g, so, pg8::AddrStd{}, E); }
                    GRID_SYNC();
                    if (EN_MIX && EN_DN && PH(9)) phase_dncombine(p, l);
                    if (EN_CROSS && PH(11)) { KW_PTRS pg8::Gemm g{(const bf16_t*)(ws + WS_MEMB), W + W_KV, 1024, 1024, 1024}; pg8::StaticOrder so; so.init(B, 8, G, cid);
                      pg8::EpiBf16<0> E{(bf16_t*)(BIG + BG_KV), 2048, mssq, 1.0f, S};
                      pg8::gemm_phase(lds, g, so, pg8::AddrStd{}, E); }
                    GRID_SYNC();
                    if (EN_MIX && PH(10)) { KW_PTRS pg8::Gemm g{YC, W + W_OUT, 1024, 1024, 1024}; pg8::StaticOrder so; so.init(256, 4, G, cid);
                      pg8::EpiRes E{X, X, X1, ssq, 1.0f};
                      pg8::gemm_phase(lds, g, so, pg8::AddrStd{}, E); }
                    if (EN_CROSS && PH(12)) { KW_PTRS pg8::Gemm g{(const bf16_t*)(BIG + BG_KV), W + W_QB, 256, 2048, 1024}; pg8::StaticOrder so; so.init(B * 4, 4, G, cid);
                      pg8::EpiBf16<0> E{(bf16_t*)(BIG + BG_WKT), 1024, nullptr, 1.0f, S};
                      pg8::gemm_phase(lds, g, so, pg8::AddrFoldK{}, E); }
                    if (EN_CROSS && PH(13)) { KW_PTRS pg8::Gemm g{W + W_OT, (const bf16_t*)(BIG + BG_KV), 256, 1024, 2048}; pg8::StaticOrder so; so.init(4, B * 4, G, cid);
                      pg8::EpiBf16<1> E{(bf16_t*)(BIG + BG_VWT), 1024, nullptr, 1.0f, S};
                      pg8::gemm_phase(lds, g, so, pg8::AddrFoldV{}, E); }
                    GRID_SYNC();
                    if (EN_CROSS && PH(14)) { KW_PTRS pg8::Gemm g{X1, (const bf16_t*)(BIG + BG_WKT), 1024, 1024, 1024}; pg8::StaticOrder so; so.init(256, 4, G, cid);
                      pg8::EpiSoftmax E{(bf16_t*)(BIG + BG_P), ssq};
                      pg8::gemm_phase(lds, g, so, pg8::AddrBatchB{lgS - 8}, E); }
                    GRID_SYNC();
                    if (EN_CROSS && PH(15)) { KW_PTRS pg8::Gemm g{(const bf16_t*)(BIG + BG_P), (const bf16_t*)(BIG + BG_VWT), 1024, 1024, 1024}; pg8::StaticOrder so; so.init(256, 4, G, cid);
                      pg8::EpiRes E{X, X, X1, ssq, 1.0f};
                      pg8::gemm_phase(lds, g, so, pg8::AddrBatchB{lgS - 8}, E); }
                    GRID_SYNC();
                }
                for (int rep = 0; rep < REP_GU; ++rep) if (EN_FFN && PH(16)) { KW_PTRS pg8::Gemm g{X1, W + (f ? W_GU2 : W_GU1), 1024, 1024, 1024}; pg8::StaticOrder so; so.init(256, 22, G, cid);
                  pg8::EpiSwiglu E{(bf16_t*)BIG, ssq};
                  pg8::gemm_phase(lds, g, so, pg8::AddrStd{}, E); }
                GRID_SYNC();
                if (EN_FFN && PH(17)) { KW_PTRS pg8::Gemm g{(const bf16_t*)BIG, W + (f ? W_D2 : W_D1), 2816, 2816, 2816}; pg8::StaticOrder so; so.init(256, 4, G, cid, 1);
                  pg8::EpiRes E{(l == 0 && f == 0) ? p.in[grp] : (const float*)X, X, X1, ssq, 0.5f};
                  pg8::gemm_phase(lds, g, so, pg8::AddrStd{}, E); }
                GRID_SYNC();
            }
        }
        if (PH(18)) phase_final(p, X);
        GRID_SYNC();
    }
}

extern "C" void kernel_launch(void* const* d_in, const int* in_sizes, int n_in, void* d_out, int out_size, void* d_ws, size_t ws_size, hipStream_t stream) {
    static int grid = 0;
    if (grid == 0) {
        if (n_in != 26 || ws_size < WS_END) { fprintf(stderr, "kernel_launch: unexpected n_in %d / ws_size %zu\n", n_in, ws_size); grid = -1; return; }
        int dev = 0, cus = 0, per_cu = 0;
        hipGetDevice(&dev); hipDeviceGetAttribute(&cus, hipDeviceAttributeMultiprocessorCount, dev);
        hipFuncSetAttribute((const void*)mega_fwd, hipFuncAttributeMaxDynamicSharedMemorySize, LDS_BYTES);
        if (hipOccupancyMaxActiveBlocksPerMultiprocessor(&per_cu, (const void*)mega_fwd, 512, LDS_BYTES) != hipSuccess || per_cu < 1) per_cu = 1;
        (void)hipGetLastError();
        grid = cus * per_cu;
    }
    if (grid < 0) return;
    hipMemsetAsync((char*)d_ws + WS_CNT, 0, 32768, stream);
    Params p{};
    for (int i = 0; i < 26; ++i) p.in[i] = (const float*)d_in[i];
    p.out = (float*)d_out; p.ws = (unsigned char*)d_ws;
    void* args[] = {&p};
    hipError_t e = hipLaunchCooperativeKernel((const void*)mega_fwd, dim3(grid), dim3(512), args, LDS_BYTES, stream);
    if (e != hipSuccess) fprintf(stderr, "cooperative launch failed: %s (grid %d)\n", hipGetErrorString(e), grid);
}
```

```cpp
#define EN_MIX 1
#ifndef REP_SYNC
#define REP_SYNC 0
#endif
#ifndef REP_GU
#define REP_GU 1
#endif
#ifndef REP_PREP
#define REP_PREP 1
#endif
#ifndef REP_SCAN
#define REP_SCAN 1
#endif
#ifndef REP_ATT
#define REP_ATT 1
#endif
#define EN_DN 1
#define EN_ATT 1
#define EN_DFT 1
#define EN_CROSS 1
#define EN_FFN 1
#include <hip/hip_runtime.h>
#include <hip/hip_cooperative_groups.h>
#include <cstdio>
#include <cstdint>
namespace cg = cooperative_groups;

#define LAS __attribute__((address_space(3)))
typedef unsigned short bf16_t;
typedef short bf16x8 __attribute__((ext_vector_type(8)));
typedef float f32x4 __attribute__((ext_vector_type(4)));
typedef float f32x16 __attribute__((ext_vector_type(16)));
typedef unsigned u32x4 __attribute__((ext_vector_type(4)));
typedef unsigned u32x2 __attribute__((ext_vector_type(2)));

#define LDS_WAIT() asm volatile("s_waitcnt lgkmcnt(0)" ::: "memory")
#define LDS_BAR() asm volatile("s_waitcnt lgkmcnt(0)\n\ts_barrier" ::: "memory")

typedef float f32x2_t __attribute__((ext_vector_type(2))); typedef __bf16 bf16x2_t __attribute__((ext_vector_type(2)));
__device__ __forceinline__ unsigned cvt_pk_bf16(float lo, float hi) { const f32x2_t v = {lo, hi}; const bf16x2_t b = __builtin_convertvector(v, bf16x2_t); return __builtin_bit_cast(unsigned, b); }
__device__ __forceinline__ bf16_t f2bf(float f) { return (bf16_t)(cvt_pk_bf16(f, f) & 0xffffu); }
__device__ __forceinline__ float bf2f(unsigned h) { return __uint_as_float(h << 16); }
__device__ __forceinline__ float bflo(unsigned w) { return __uint_as_float(w << 16); }
__device__ __forceinline__ float bfhi(unsigned w) { return __uint_as_float(w & 0xffff0000u); }
__device__ __forceinline__ float shx(float v, int mask, int lane) { return __int_as_float(__builtin_amdgcn_ds_bpermute((lane ^ mask) << 2, __float_as_int(v))); }
__device__ __forceinline__ float wave_sum(float v, int lane) {
#pragma unroll
    for (int o = 1; o < 64; o <<= 1) v += shx(v, o, lane);
    return v;
}
__device__ __forceinline__ int otid() { int t = threadIdx.x; asm volatile("" : "+v"(t)); return t; }
__device__ __forceinline__ int obid() { int t = blockIdx.x; asm volatile("" : "+s"(t)); return t; }
__device__ __forceinline__ int crow(int r, int hi) { return (r & 3) + 8 * (r >> 2) + 4 * hi; }
__device__ __forceinline__ int pos16(int e) { return (((e >> 2) & 1) << 3) | (((e >> 3) & 1) << 2) | (e & 3); }
__device__ __forceinline__ bf16x8 pack8(float a0, float a1, float a2, float a3, float a4, float a5, float a6, float a7) {
    u32x4 w; w.x = cvt_pk_bf16(a0, a1); w.y = cvt_pk_bf16(a2, a3); w.z = cvt_pk_bf16(a4, a5); w.w = cvt_pk_bf16(a6, a7);
    return __builtin_bit_cast(bf16x8, w);
}
__device__ __forceinline__ float row_rstd(const float* ssq, int row) {
    const f32x4* p = (const f32x4*)(ssq + (size_t)row * 16);
    const f32x4 a = p[0], b = p[1], c = p[2], d = p[3];
    const float s = ((a.x + a.y) + (a.z + a.w)) + ((b.x + b.y) + (b.z + b.w)) + ((c.x + c.y) + (c.z + c.w)) + ((d.x + d.y) + (d.z + d.w));
    return rsqrtf(s * (1.0f / 1024.0f) + 1e-6f);
}

__device__ __forceinline__ void load_rstd8(const float* ssq, int row0, int fq, int lane, float (&rs)[8]) {
    f32x4 v[8];
#pragma unroll
    for (int g = 0; g < 8; ++g) v[g] = *(const f32x4*)(ssq + (size_t)(row0 + (g >> 2) * 128 + (g & 3) * 16) * 16 + fq * 4);
#pragma unroll
    for (int g = 0; g < 8; ++g) { float t = (v[g][0] + v[g][1]) + (v[g][2] + v[g][3]); t += shx(t, 16, lane); t += shx(t, 32, lane); rs[g] = rsqrtf(t * (1.0f / 1024.0f) + 1e-6f); }
}
namespace pg8 {
constexpr int BM = 256, BK = 64, HALF = 128, HTB = HALF * BK * 2, STAGE_BYTES = 8 * HTB, NXCD = 8, WGM = 8;
__host__ __device__ __forceinline__ int lds_byte(int r, int c) { const int st = (r >> 4) * 2 + (c >> 5), rr = r & 15, cc = c & 31, ob = rr * 64 + cc * 2; return st * 1024 + (ob ^ (((ob >> 9) & 1) << 5)); }
__host__ __device__ __forceinline__ void stage_rc(int b, int& R, int& C) { const int st = b / 1024, sb = b % 1024, swz = sb ^ (((sb >> 9) & 1) << 5); R = (st >> 1) * 16 + swz / 64; C = (st & 1) * 32 + (swz % 64) / 2; }
__host__ __device__ __forceinline__ int perm32(int rho) { const int n = rho >> 4, i = rho & 15; return 8 * (i >> 2) + 4 * n + (i & 3); }

struct Unit { int pm, pn; };
struct Gemm { const bf16_t* A; const bf16_t* Bt; int K, lda, ldb; };

struct StaticOrder {
    int nM, nN, nwg, G, c, rev;
    __device__ void init(int nM_, int nN_, int G_, int c_, int rev_ = 0) { nM = nM_; nN = nN_; nwg = nM * nN; G = G_; c = c_; rev = rev_; }
    __device__ bool next(int i, Unit& u) const {
        const long L = (long)i * G + c; if (L >= nwg) return false;
        int wgid = (int)L; { const int q = nwg / NXCD, r = nwg % NXCD, xcd = wgid % NXCD, off = wgid / NXCD; wgid = (xcd < r ? xcd * (q + 1) : r * (q + 1) + (xcd - r) * q) + off; }
        if (rev) wgid = nwg - 1 - wgid;
        const int nig = WGM * nN, gid = wgid / nig, fm = gid * WGM, gsz = (nM - fm) < WGM ? (nM - fm) : WGM;
        u.pm = fm + ((wgid % nig) % gsz); u.pn = (wgid % nig) / gsz; return true;
    }
};

struct AddrStd { __device__ __forceinline__ void get(const Gemm& g, const Unit& u, const char*& a, const char*& b) const {
    a = (const char*)g.A + (size_t)u.pm * 256 * g.lda * 2; b = (const char*)g.Bt + (size_t)u.pn * 256 * g.ldb * 2; } };
struct AddrBatchB { int lgtpb; __device__ __forceinline__ void get(const Gemm& g, const Unit& u, const char*& a, const char*& b) const {
    a = (const char*)g.A + (size_t)u.pm * 256 * g.lda * 2; b = (const char*)g.Bt + ((size_t)(u.pm >> lgtpb) * 1048576 + (size_t)u.pn * 256 * 1024) * 2; } };
struct AddrFoldK { __device__ __forceinline__ void get(const Gemm& g, const Unit& u, const char*& a, const char*& b) const {
    a = (const char*)g.A + ((size_t)(u.pm >> 2) * 256 * 2048 + (size_t)(u.pm & 3) * 256) * 2; b = (const char*)g.Bt + ((size_t)u.pn * 256 * 1024 + (size_t)(u.pm & 3) * 256) * 2; } };
struct AddrFoldV { __device__ __forceinline__ void get(const Gemm& g, const Unit& u, const char*& a, const char*& b) const {
    a = (const char*)g.A + ((size_t)u.pm * 256 * 1024 + (size_t)(u.pn & 3) * 256) * 2; b = (const char*)g.Bt + ((size_t)(u.pn >> 2) * 256 * 2048 + 1024 + (size_t)(u.pn & 3) * 256) * 2; } };

typedef f32x4 Acc[2][2][4][2];

struct EpiSwiglu {
    static constexpr bool PERM = true;
    bf16_t* H; const float* ssq;
    __device__ __forceinline__ void operator()(Acc& acc, const Unit& u, int wr, int wc, int fr, int fq, LAS unsigned char* xch) const {
        const int row0 = u.pm * 256 + wr * 64 + fr, col0 = u.pn * 128 + wc * 32 + 8 * fq;
        float rs8[8]; load_rstd8(ssq, row0, fq, fq * 16 + fr, rs8);
#pragma unroll
        for (int ai = 0; ai < 2; ++ai)
#pragma unroll
            for (int m = 0; m < 4; ++m) {
                const int row = row0 + ai * 128 + m * 16; const float rs = rs8[ai * 4 + m];
                float hv[8];
#pragma unroll
                for (int n = 0; n < 2; ++n)
#pragma unroll
                    for (int j = 0; j < 4; ++j) { const float g = acc[ai][0][m][n][j] * rs, uu = acc[ai][1][m][n][j] * rs;
                        hv[n * 4 + j] = g * __builtin_amdgcn_rcpf(1.0f + __expf(-g)) * uu; }
                u32x4 w; w.x = cvt_pk_bf16(hv[0], hv[1]); w.y = cvt_pk_bf16(hv[2], hv[3]); w.z = cvt_pk_bf16(hv[4], hv[5]); w.w = cvt_pk_bf16(hv[6], hv[7]);
                *(u32x4*)(H + (size_t)row * 2816 + col0) = w; asm volatile("" ::: "memory");
            }
    }
};
struct EpiRes {
    static constexpr bool PERM = false; static constexpr int PD = 3;
    const float* Xb; float* X; bf16_t* XB; float* ssq; float alpha;
    __device__ __forceinline__ void operator()(Acc& acc, const Unit& u, int wr, int wc, int fr, int fq, LAS unsigned char* xch) const {
        const int row0 = u.pm * 256 + wr * 64 + fr, col0 = u.pn * 256 + wc * 32 + 4 * fq;
        f32x4 pre[PD][4];
#pragma unroll
        for (int g = 0; g < PD; ++g) { const float* xr = Xb + (size_t)(row0 + (g >> 2) * 128 + (g & 3) * 16) * 1024 + col0;
#pragma unroll
            for (int q = 0; q < 4; ++q) pre[g][q] = *(const f32x4*)(xr + (q >> 1) * 128 + (q & 1) * 16); }
#pragma unroll
        for (int g = 0; g < 8; ++g) {
            const int ai = g >> 2, m = g & 3; const int row = row0 + ai * 128 + m * 16; float s = 0.f;
            float* xr = X + (size_t)row * 1024 + col0; bf16_t* br = XB + (size_t)row * 1024 + col0;
            f32x4 v[4];
#pragma unroll
            for (int q = 0; q < 4; ++q) v[q] = pre[g % PD][q] + acc[ai][q >> 1][m][q & 1] * alpha;
            if (g + PD < 8) { const int gn = g + PD; const float* xn = Xb + (size_t)(row0 + (gn >> 2) * 128 + (gn & 3) * 16) * 1024 + col0;
#pragma unroll
                for (int q = 0; q < 4; ++q) pre[g % PD][q] = *(const f32x4*)(xn + (q >> 1) * 128 + (q & 1) * 16); }
#pragma unroll
            for (int q = 0; q < 4; ++q) {
                *(f32x4*)(xr + (q >> 1) * 128 + (q & 1) * 16) = v[q];
                if (XB) { u32x2 w; w.x = cvt_pk_bf16(v[q][0], v[q][1]); w.y = cvt_pk_bf16(v[q][2], v[q][3]); *(u32x2*)(br + (q >> 1) * 128 + (q & 1) * 16) = w; }
                s += (v[q][0] * v[q][0] + v[q][1] * v[q][1]) + (v[q][2] * v[q][2] + v[q][3] * v[q][3]);
            }
            s += shx(s, 16, fq * 16 + fr); s += shx(s, 32, fq * 16 + fr);
            if (fq == 0) ssq[(size_t)row * 16 + u.pn * 4 + wc] = s;
            asm volatile("" ::: "memory");
        }
    }
};
template <int MODE> struct EpiBf16 {
    static constexpr bool PERM = true;
    bf16_t* O; int ld; const float* ssq; float scale; int S;
    __device__ __forceinline__ void operator()(Acc& acc, const Unit& u, int wr, int wc, int fr, int fq, LAS unsigned char* xch) const {
        int rowb, colb;
        if (MODE == 0) { rowb = u.pm * 256; colb = u.pn * 256; } else if (MODE == 1) { rowb = (u.pn >> 2) * 1024 + u.pm * 256; colb = (u.pn & 3) * 256; } else { rowb = u.pn * S + u.pm * 256; colb = 0; }
        const int rl0 = wr * 64 + fr, col0 = colb + wc * 32 + 8 * fq;
        float rs8[8];
        if (ssq) load_rstd8(ssq, u.pm * 256 + rl0, fq, fq * 16 + fr, rs8);
#pragma unroll
        for (int ai = 0; ai < 2; ++ai)
#pragma unroll
            for (int m = 0; m < 4; ++m) {
                const int rl = rl0 + ai * 128 + m * 16; float rs = scale; if (ssq) rs *= rs8[ai * 4 + m];
                bf16_t* rowp = O + (size_t)(rowb + rl) * ld + col0;
#pragma unroll
                for (int bj = 0; bj < 2; ++bj) { const f32x4 v0 = acc[ai][bj][m][0] * rs, v1 = acc[ai][bj][m][1] * rs;
                    u32x4 w; w.x = cvt_pk_bf16(v0[0], v0[1]); w.y = cvt_pk_bf16(v0[2], v0[3]); w.z = cvt_pk_bf16(v1[0], v1[1]); w.w = cvt_pk_bf16(v1[2], v1[3]);
                    *(u32x4*)(rowp + bj * 128) = w; } asm volatile("" ::: "memory");
            }
    }
};
struct EpiWin {
    static constexpr bool PERM = true;
    bf16_t* Z; bf16_t* FT; bf16_t* VT; float* AB; const float* ssq; int S, lgS;
    __device__ __forceinline__ void operator()(Acc& acc, const Unit& u, int wr, int wc, int fr, int fq, LAS unsigned char* xch) const {
        const int pn = u.pn; const int row0 = u.pm * 256 + wr * 64 + fr;
        float rs8[8]; load_rstd8(ssq, row0, fq, fq * 16 + fr, rs8);
#pragma unroll
        for (int ai = 0; ai < 2; ++ai)
#pragma unroll
            for (int m = 0; m < 4; ++m) {
                const int row = row0 + ai * 128 + m * 16; const float rs = rs8[ai * 4 + m];
                const int b = row >> lgS, nloc = row & (S - 1);
#pragma unroll
                for (int bj = 0; bj < 2; ++bj) {
                    const f32x4 v0 = acc[ai][bj][m][0] * rs, v1 = acc[ai][bj][m][1] * rs; const int cl = bj * 128 + wc * 32 + 8 * fq;
                    const float vv[8] = {v0[0], v0[1], v0[2], v0[3], v1[0], v1[1], v1[2], v1[3]};
                    if (pn < 7 && !(pn == 2 && bj == 1)) {
                        u32x4 w; w.x = cvt_pk_bf16(vv[0], vv[1]); w.y = cvt_pk_bf16(vv[2], vv[3]); w.z = cvt_pk_bf16(vv[4], vv[5]); w.w = cvt_pk_bf16(vv[6], vv[7]);
                        *(u32x4*)(Z + (size_t)row * 2048 + pn * 256 + cl) = w;
                    } else if (pn == 2) {
                        const int cv = cl - 128;
#pragma unroll
                        for (int e = 0; e < 8; ++e) VT[((size_t)(b * 128 + cv + e) << lgS) + nloc] = f2bf(vv[e]);
                    } else if (pn == 7) {
                        if (cl < 16) { *(f32x4*)(AB + (size_t)row * 16 + cl) = v0; *(f32x4*)(AB + (size_t)row * 16 + cl + 4) = v1; }
                    } else {
                        const int part = pn - 8;
#pragma unroll
                        for (int e = 0; e < 8; ++e) FT[((size_t)(b * 256 + cl + e) << (lgS + 1)) + ((size_t)part << lgS) + nloc] = f2bf(vv[e]);
                    }
                } asm volatile("" ::: "memory");
            }
    }
};
struct EpiSoftmax {
    static constexpr bool PERM = true;
    bf16_t* P; const float* ssq;
    __device__ __forceinline__ void operator()(Acc& acc, const Unit& u, int wr, int wc, int fr, int fq, LAS unsigned char* xch) const {
        LAS float* xm = (LAS float*)xch; LAS float* xs = xm + 1024;
        const int rl0 = wr * 64 + fr;
        float rs8[8]; load_rstd8(ssq, u.pm * 256 + rl0, fq, fq * 16 + fr, rs8);
#pragma unroll
        for (int ai = 0; ai < 2; ++ai)
#pragma unroll
            for (int m = 0; m < 4; ++m) {
                const int rl = rl0 + ai * 128 + m * 16; const float rs = rs8[ai * 4 + m]; float mx = -INFINITY;
#pragma unroll
                for (int bj = 0; bj < 2; ++bj)
#pragma unroll
                    for (int n = 0; n < 2; ++n) { const f32x4 v = acc[ai][bj][m][n] * rs; acc[ai][bj][m][n] = v; mx = fmaxf(mx, fmaxf(fmaxf(v[0], v[1]), fmaxf(v[2], v[3]))); }
                mx = fmaxf(mx, shx(mx, 16, fq * 16 + fr)); mx = fmaxf(mx, shx(mx, 32, fq * 16 + fr));
                if (fq == 0) xm[rl * 4 + wc] = mx; asm volatile("" ::: "memory");
            }
        LDS_BAR();
#pragma unroll
        for (int ai = 0; ai < 2; ++ai)
#pragma unroll
            for (int m = 0; m < 4; ++m) {
                const int rl = rl0 + ai * 128 + m * 16; const f32x4 q = *(LAS f32x4*)(xm + rl * 4);
                const float mx = fmaxf(fmaxf(q[0], q[1]), fmaxf(q[2], q[3])); float s = 0.f;
#pragma unroll
                for (int bj = 0; bj < 2; ++bj)
#pragma unroll
                    for (int n = 0; n < 2; ++n) { f32x4 v = acc[ai][bj][m][n];
#pragma unroll
                        for (int j = 0; j < 4; ++j) v[j] = __builtin_amdgcn_exp2f(v[j] - mx);
                        acc[ai][bj][m][n] = v; s += (v[0] + v[1]) + (v[2] + v[3]); }
                s += shx(s, 16, fq * 16 + fr); s += shx(s, 32, fq * 16 + fr);
                if (fq == 0) xs[rl * 4 + wc] = s; asm volatile("" ::: "memory");
            }
        LDS_BAR();
        const int col0 = u.pn * 256 + wc * 32 + 8 * fq;
#pragma unroll
        for (int ai = 0; ai < 2; ++ai)
#pragma unroll
            for (int m = 0; m < 4; ++m) {
                const int rl = rl0 + ai * 128 + m * 16; const f32x4 q = *(LAS f32x4*)(xs + rl * 4);
                const float inv = 1.0f / ((q[0] + q[1]) + (q[2] + q[3]));
                bf16_t* rowp = P + (size_t)(u.pm * 256 + rl) * 1024 + col0;
#pragma unroll
                for (int bj = 0; bj < 2; ++bj) { const f32x4 v0 = acc[ai][bj][m][0] * inv, v1 = acc[ai][bj][m][1] * inv;
                    u32x4 w; w.x = cvt_pk_bf16(v0[0], v0[1]); w.y = cvt_pk_bf16(v0[2], v0[3]); w.z = cvt_pk_bf16(v1[0], v1[1]); w.w = cvt_pk_bf16(v1[2], v1[3]);
                    *(u32x4*)(rowp + bj * 128) = w; } asm volatile("" ::: "memory");
            }
    }
};

template <class Epi, class Addr>
__device__ __forceinline__ void gemm_phase(LAS unsigned char* lds, const Gemm g, const StaticOrder& S, const Addr& AD, const Epi& E) {
    const int tid = otid(), wid = __builtin_amdgcn_readfirstlane(tid >> 6), lane = tid & 63, wr = wid >> 2, wc = wid & 3, fr = lane & 15, fq = lane >> 4;
    int Kq = g.K; asm volatile("" : "+s"(Kq));
    const int nt = Kq / BK;
    unsigned voffA[2], voffB[2];
#pragma unroll
    for (int i = 0; i < 2; ++i) { int R, C; stage_rc(tid * 16 + i * 8192, R, C); const int Rb = Epi::PERM ? ((R & ~31) + perm32(R & 31)) : R;
        voffA[i] = (unsigned)(R * g.lda + C) * 2u; voffB[i] = (unsigned)(Rb * g.ldb + C) * 2u; }
    const size_t kstep = (size_t)(BK * 2);
    const size_t hstepA = (size_t)HALF * g.lda * 2, hstepB = (size_t)HALF * g.ldb * 2;
    const unsigned ldsw = (unsigned)wid * 1024u;
    const int aoff = lds_byte(wr * 64 + fr, fq * 8), boff = lds_byte(wc * 32 + fr, fq * 8);
    LAS unsigned char* xch = lds + STAGE_BYTES;
#define PG8_SA(b, h) (((b) * 2 + (h)) * HTB)
#define PG8_SB(b, h) ((4 + (b) * 2 + (h)) * HTB)
#define PG8_STAGE(bufoff, gbase, voff) do { _Pragma("unroll") for (int _i = 0; _i < 2; ++_i) \
        __builtin_amdgcn_global_load_lds((const unsigned*)((const char*)(gbase) + (voff)[_i]), (LAS unsigned*)(lds + (bufoff) + ldsw + _i * 8192), 16, 0, 0); } while (0)
#define PG8_LDA(dst, b, h) do { _Pragma("unroll") for (int m = 0; m < 4; ++m) _Pragma("unroll") for (int k = 0; k < 2; ++k) dst[m][k] = *(const LAS bf16x8*)(lds + PG8_SA(b, h) + aoff + m * 2048 + k * 1024); } while (0)
#define PG8_LDB(dst, b, h) do { _Pragma("unroll") for (int n = 0; n < 2; ++n) _Pragma("unroll") for (int k = 0; k < 2; ++k) dst[n][k] = *(const LAS bf16x8*)(lds + PG8_SB(b, h) + boff + n * 2048 + k * 1024); } while (0)
#define PG8_MMA(ai, bj, At, Bt) do { __builtin_amdgcn_s_setprio(1); _Pragma("unroll") for (int m = 0; m < 4; ++m) _Pragma("unroll") for (int n = 0; n < 2; ++n) _Pragma("unroll") for (int k = 0; k < 2; ++k) \
        acc[ai][bj][m][n] = __builtin_amdgcn_mfma_f32_16x16x32_bf16(Bt[n][k], At[m][k], acc[ai][bj][m][n], 0, 0, 0); __builtin_amdgcn_s_setprio(0); } while (0)
#define PG8_WAIT_V(n) asm volatile("s_waitcnt vmcnt(" #n ")" ::: "memory")
#define PG8_WAIT_L(n) asm volatile("s_waitcnt lgkmcnt(" #n ")" ::: "memory")
#define PG8_BAR __builtin_amdgcn_s_barrier()
#define PG8_SCHED __builtin_amdgcn_sched_barrier(0)
    Unit cur, nxt; int ui = 0;
    if (!S.next(0, cur)) return;
    Acc acc;
#pragma unroll
    for (int a = 0; a < 2; ++a)
#pragma unroll
        for (int b = 0; b < 2; ++b)
#pragma unroll
            for (int m = 0; m < 4; ++m)
#pragma unroll
                for (int n = 0; n < 2; ++n) acc[a][b][m][n] = (f32x4){0.f, 0.f, 0.f, 0.f};
    bf16x8 At[4][2], B0[2][2], B1[2][2];
    const char* cA; const char* cB; AD.get(g, cur, cA, cB);
    PG8_STAGE(PG8_SB(0, 0), cB, voffB); PG8_STAGE(PG8_SB(0, 1), cB + hstepB, voffB); PG8_STAGE(PG8_SA(0, 0), cA, voffA); PG8_STAGE(PG8_SA(0, 1), cA + hstepA, voffA);
    if (wr == 1) PG8_BAR;
    PG8_WAIT_V(2); PG8_BAR;
    PG8_STAGE(PG8_SB(1, 0), cB + kstep, voffB); PG8_STAGE(PG8_SA(1, 0), cA + kstep, voffA); PG8_STAGE(PG8_SB(1, 1), cB + hstepB + kstep, voffB);
    PG8_WAIT_V(6); PG8_BAR;
    for (;;) {
        const bool has_next = S.next(ui + 1, nxt);
        const char* nA = cA; const char* nB = cB; if (has_next) AD.get(g, nxt, nA, nB);
        for (int t = 0; t < nt; t += 2) {
            const bool last = (t == nt - 2);
            const char* a1 = cA + (size_t)(t + 1) * kstep;
            const char* a2 = last ? nA : cA + (size_t)(t + 2) * kstep; const char* b2 = last ? nB : cB + (size_t)(t + 2) * kstep;
            const char* a3 = a2 + kstep; const char* b3 = b2 + kstep;
            PG8_LDB(B0, 0, 0); PG8_LDB(B1, 0, 1); PG8_SCHED; PG8_LDA(At, 0, 0); PG8_STAGE(PG8_SA(1, 1), a1 + hstepA, voffA);
            PG8_WAIT_V(8); PG8_WAIT_L(0); PG8_BAR; PG8_MMA(0, 0, At, B0); PG8_MMA(0, 1, At, B1); PG8_BAR; PG8_SCHED;
            PG8_LDA(At, 0, 1); PG8_STAGE(PG8_SB(0, 0), b2, voffB); PG8_STAGE(PG8_SB(0, 1), b2 + hstepB, voffB); PG8_STAGE(PG8_SA(0, 0), a2, voffA);
            PG8_WAIT_V(8); PG8_WAIT_L(0); PG8_BAR; PG8_MMA(1, 0, At, B0); PG8_MMA(1, 1, At, B1); PG8_BAR; PG8_SCHED;
            PG8_LDB(B0, 1, 0); PG8_LDB(B1, 1, 1); PG8_SCHED; PG8_LDA(At, 1, 0); PG8_STAGE(PG8_SA(0, 1), a2 + hstepA, voffA);
            PG8_WAIT_V(8); PG8_WAIT_L(0); PG8_BAR; PG8_MMA(0, 0, At, B0); PG8_MMA(0, 1, At, B1); PG8_BAR; PG8_SCHED;
            PG8_LDA(At, 1, 1); PG8_STAGE(PG8_SB(1, 0), b3, voffB); PG8_STAGE(PG8_SB(1, 1), b3 + hstepB, voffB); PG8_STAGE(PG8_SA(1, 0), a3, voffA);
            PG8_WAIT_V(8); PG8_WAIT_L(0); PG8_BAR; PG8_MMA(1, 0, At, B0); PG8_MMA(1, 1, At, B1); PG8_BAR; PG8_SCHED;
        }
        if (wr == 0) PG8_BAR;
        { int fr_ = fr, fq_ = fq; asm volatile("" : "+v"(fr_), "+v"(fq_));
          E(acc, cur, wr, wc, fr_, fq_, xch); }
        if (!has_next) break;
#pragma unroll
        for (int a = 0; a < 2; ++a)
#pragma unroll
            for (int b = 0; b < 2; ++b)
#pragma unroll
                for (int m = 0; m < 4; ++m)
#pragma unroll
                    for (int n = 0; n < 2; ++n) acc[a][b][m][n] = (f32x4){0.f, 0.f, 0.f, 0.f};
        cur = nxt; cA = nA; cB = nB; ++ui;
        if (wr == 1) PG8_BAR;
    }
    PG8_WAIT_V(0);
    PG8_BAR;
#undef PG8_SA
#undef PG8_SB
#undef PG8_STAGE
#undef PG8_LDA
#undef PG8_LDB
#undef PG8_MMA
#undef PG8_WAIT_V
#undef PG8_WAIT_L
#undef PG8_BAR
#undef PG8_SCHED
}
}

constexpr int NTOK = 65536;
constexpr size_t MiB = 1u << 20;
constexpr size_t WS_SSQ = 0, WS_MSSQ = 4 * MiB, WS_PQ = 5 * MiB, WS_GL = 5 * MiB + 512 * 1024, WS_CNT = 6 * MiB;
constexpr size_t WS_W = 8 * MiB, WS_X1 = 56 * MiB, WS_YC = 184 * MiB, WS_BIG = 312 * MiB, WS_DN = 664 * MiB, WS_DFT2 = 984 * MiB, WS_MEMB = 1000 * MiB, WS_AB = 1016 * MiB, WS_END = 1020 * MiB;
constexpr size_t BG_Z = 0, BG_FT = 256 * MiB, BG_VT = 320 * MiB;
constexpr size_t BG_P = 0, BG_WKT = 128 * MiB, BG_VWT = 192 * MiB, BG_KV = 256 * MiB;
constexpr size_t W_GU1 = 0, W_D1 = 5767168, W_IN = 8650752, W_OUT = 11272192, W_QB = 12320768, W_KV = 13369344, W_OT = 15466496, W_GU2 = 16515072, W_D2 = 22282240;
#ifndef PHASE_SEL
#define PHASE_SEL -1
#endif
#define PH(n) (PHASE_SEL < 0 || PHASE_SEL == (n))
constexpr int LDS_BYTES = 147456;
constexpr int XCH_OFF = 131072, CNT_OFF = 140000, XB_LDS_OFF = 143360;
constexpr float QSCALE_GQA = 0.125f * 1.4426950408889634f;
constexpr float QSCALE_MEM = 0.0625f * 1.4426950408889634f;

struct Params { const float* in[26]; float* out; unsigned char* ws; };
typedef __attribute__((address_space(1))) unsigned char gu8_t;
__device__ __forceinline__ unsigned char* ows(const Params& p) { gu8_t* w = (gu8_t*)p.ws; asm volatile("" : "+s"(w)); return (unsigned char*)w; }

__device__ __forceinline__ void phase_init(const Params& p, int grp, int S, int lgS, int B, float* X, bf16_t* DFT) {
    unsigned char* const ws_ = ows(p);
    const int tid = otid(), lane = tid & 63, wid = tid >> 6;
    const int gw = obid() * 8 + wid, NGW = gridDim.x * 8;
    unsigned char* ws = ws_;
    const float* xin = p.in[grp]; bf16_t* X1 = (bf16_t*)(ws + WS_X1); float* ssq = (float*)(ws + WS_SSQ);
    for (int row = gw; row < NTOK; row += NGW) {
        const f32x4* xr = (const f32x4*)(xin + (size_t)row * 1024) + lane; f32x4 v[4]; float s = 0.f;
#pragma unroll
        for (int j = 0; j < 4; ++j) { v[j] = xr[64 * j]; s += (v[j][0] * v[j][0] + v[j][1] * v[j][1]) + (v[j][2] * v[j][2] + v[j][3] * v[j][3]); }
        s = wave_sum(s, lane);
        u32x2* ob = (u32x2*)(X1 + (size_t)row * 1024) + lane;
#pragma unroll
        for (int j = 0; j < 4; ++j) { u32x2 w; w.x = cvt_pk_bf16(v[j][0], v[j][1]); w.y = cvt_pk_bf16(v[j][2], v[j][3]); ob[64 * j] = w; }
        if (lane < 16) ssq[(size_t)row * 16 + lane] = (lane == 0) ? s : 0.f;
    }
    const float* memin = p.in[2 + grp]; bf16_t* MB = (bf16_t*)(ws + WS_MEMB); float* mssq = (float*)(ws + WS_MSSQ);
    for (int row = gw; row < B * 256; row += NGW) {
        const f32x4* xr = (const f32x4*)(memin + (size_t)row * 1024) + lane; f32x4 v[4]; float s = 0.f;
#pragma unroll
        for (int j = 0; j < 4; ++j) { v[j] = xr[64 * j]; s += (v[j][0] * v[j][0] + v[j][1] * v[j][1]) + (v[j][2] * v[j][2] + v[j][3] * v[j][3]); }
        s = wave_sum(s, lane);
        u32x2* ob = (u32x2*)(MB + (size_t)row * 1024) + lane;
#pragma unroll
        for (int j = 0; j < 4; ++j) { u32x2 w; w.x = cvt_pk_bf16(v[j][0], v[j][1]); w.y = cvt_pk_bf16(v[j][2], v[j][3]); ob[64 * j] = w; }
        if (lane < 16) mssq[(size_t)row * 16 + lane] = (lane == 0) ? s : 0.f;
    }
    const size_t nvec = ((size_t)S * (size_t)S) >> 3; const size_t NT = (size_t)gridDim.x * 512;
    const float invS = 1.0f / (float)S; const int hS = S >> 1;
    for (size_t i = (size_t)obid() * 512 + tid; i < nvec; i += NT) {
        const int j = (int)(i >> (lgS - 3)); const int c0 = (int)(i & (size_t)((S >> 3) - 1)) * 8;
        float v[8];
#pragma unroll
        for (int e = 0; e < 8; ++e) { const int k = c0 + e; const bool sn = k > hS; const int kk = sn ? k - hS : k; const int idx = (j * kk) & (S - 1); const float fr = (float)idx * invS;
            v[e] = sn ? -__builtin_amdgcn_sinf(fr) : __builtin_amdgcn_cosf(fr); }
        u32x4 w; w.x = cvt_pk_bf16(v[0], v[1]); w.y = cvt_pk_bf16(v[2], v[3]); w.z = cvt_pk_bf16(v[4], v[5]); w.w = cvt_pk_bf16(v[6], v[7]);
        *(u32x4*)(DFT + (size_t)j * S + c0) = w;
    }
}

__device__ __forceinline__ void phase_fold(const Params& p, int S, int lgS, int B, LAS unsigned char* lds) {
    unsigned char* const ws_ = ows(p);
    const int tid = otid(); bf16_t* FT = (bf16_t*)(ws_ + WS_BIG + BG_FT); const int hS = S >> 1;
    LAS bf16_t* rowl = (LAS bf16_t*)lds;
    for (int row = obid(); row < B * 256; row += gridDim.x) {
        bf16_t* rp = FT + (size_t)row * 2 * S;
        for (int c = tid; c < (S >> 2); c += 512) *(LAS u32x4*)(rowl + c * 8) = *(const u32x4*)(rp + c * 8);
        __syncthreads();
        for (int k = tid; k < S; k += 512) {
            float v;
            if (k <= hS) { v = bf2f(rowl[k]); if (k != 0 && k != hS) v += bf2f(rowl[S - k]); }
            else { const int kk = k - hS; v = bf2f(rowl[S + kk]) - bf2f(rowl[2 * S - kk]); }
            rp[k] = f2bf(v);
        }
        __syncthreads();
    }
}

__device__ __forceinline__ void phase_pq(const Params& p, int l) {
    unsigned char* const ws_ = ows(p);
    float* PQ = (float*)(ws_ + WS_PQ) + (size_t)l * 32768; const float* fw = p.in[9] + (size_t)l * 16384;
    for (int o = obid() * 512 + otid(); o < 32768; o += gridDim.x * 512) {
        const int part = o >> 14, g = (o >> 12) & 3, c = (o >> 6) & 63, d = o & 63; float acc = 0.f;
        for (int e = 0; e < 64; ++e) { const float fr = (float)((c * e) & 63) * (1.0f / 64.0f); const float t = part ? __builtin_amdgcn_sinf(fr) : __builtin_amdgcn_cosf(fr);
            acc += t * fw[(g * 64 + e) * 64 + d]; }
        PQ[o] = acc;
    }
}

__device__ __forceinline__ void tr_item(const float* W, int K, int Nsrc, int srccol, int nvalid, bf16_t* WT, int destrow0, const float* gain, LAS float* scr, int kb, int lane) {
    const int k0 = 64 * kb;
#pragma unroll 8
    for (int i = 0; i < 32; ++i) { const int kk = 2 * i + (lane >> 5); const int c = lane & 31;
        float v = (c < nvalid) ? W[(size_t)(k0 + kk) * Nsrc + srccol + c] : 0.f; if (gain) v *= gain[k0 + kk]; scr[kk * 33 + c] = v; }
    LDS_WAIT();
    const int c = lane & 7;
#pragma unroll
    for (int j = 0; j < 4; ++j) { const int n = (lane >> 3) + 8 * j; const LAS float* s = scr + (8 * c) * 33 + n;
        u32x4 o; o.x = cvt_pk_bf16(s[0 * 33], s[1 * 33]); o.y = cvt_pk_bf16(s[2 * 33], s[3 * 33]); o.z = cvt_pk_bf16(s[4 * 33], s[5 * 33]); o.w = cvt_pk_bf16(s[6 * 33], s[7 * 33]);
        *(u32x4*)(WT + (size_t)(destrow0 + n) * K + k0 + 8 * c) = o; }
    LDS_WAIT();
}
__device__ __forceinline__ void phase_weights(const Params& p, int l, LAS unsigned char* lds) {
    unsigned char* const ws_ = ows(p);
    const int tid = otid(), lane = tid & 63, wid = tid >> 6;
    const int gw = obid() * 8 + wid, NGW = gridDim.x * 8;
    LAS float* scr = (LAS float*)(lds + wid * 16384);
    bf16_t* W = (bf16_t*)(ws_ + WS_W);
    const float* ffn1n = p.in[4] + l * 1024; const float* gu1 = p.in[5] + (size_t)l * 1024 * 5632; const float* d1 = p.in[6] + (size_t)l * 2816 * 1024;
    const float* mixn = p.in[7] + l * 1024; const float* win = p.in[8] + (size_t)l * 1024 * 2064; const float* wout = p.in[16] + (size_t)l * 1048576;
    const float* mnx = p.in[17] + l * 1024; const float* mnm = p.in[18] + l * 1024; const float* wq = p.in[19] + (size_t)l * 1048576;
    const float* wkv = p.in[20] + (size_t)l * 2097152; const float* wo = p.in[21] + (size_t)l * 1048576;
    const float* ffn2n = p.in[22] + l * 1024; const float* gu2 = p.in[23] + (size_t)l * 1024 * 5632; const float* d2 = p.in[24] + (size_t)l * 2816 * 1024;
    for (int it = gw; it < 11520; it += NGW) {
        int r = it;
        if (r < 2816 || (r >= 7296 && r < 10112)) {
            const bool second = r >= 7296; if (second) r -= 7296;
            const int kb = r / 176, nb = r % 176, tile = nb >> 3, within = nb & 7, half = within >> 2, j32 = within & 3;
            tr_item(second ? gu2 : gu1, 1024, 5632, half * 2816 + tile * 128 + j32 * 32, 32, W + (second ? W_GU2 : W_GU1), nb * 32, second ? ffn2n : ffn1n, scr, kb, lane);
        } else if ((r >= 2816 && r < 4224) || r >= 10112) {
            const bool second = r >= 10112; r -= second ? 10112 : 2816;
            const int kb = r / 32, nb = r % 32;
            tr_item(second ? d2 : d1, 2816, 1024, nb * 32, 32, W + (second ? W_D2 : W_D1), nb * 32, nullptr, scr, kb, lane);
        } else if (r < 5248) {
            r -= 4224; const int kb = r / 64, nb = r % 64, d0 = nb * 32; int src, nv = 32;
            if (d0 < 512) src = 1296 + d0; else if (d0 < 640) src = 1808 + (d0 - 512); else if (d0 < 768) src = 1936 + (d0 - 640);
            else if (d0 < 1536) src = 256 + (d0 - 768); else if (d0 < 1792) src = 1040 + (d0 - 1536); else if (d0 == 1792) { src = 1024; nv = 16; } else { src = 0; nv = 0; }
            tr_item(win, 1024, 2064, src, nv, W + W_IN, d0, mixn, scr, kb, lane);
        } else if (r < 5760) { r -= 5248; tr_item(wout, 1024, 1024, (r % 32) * 32, 32, W + W_OUT, (r % 32) * 32, nullptr, scr, r / 32, lane);
        } else if (r < 6784) { r -= 5760; tr_item(wkv, 1024, 2048, (r % 64) * 32, 32, W + W_KV, (r % 64) * 32, mnm, scr, r / 64, lane);
        } else { r -= 6784; tr_item(wo, 1024, 1024, (r % 32) * 32, 32, W + W_OT, (r % 32) * 32, nullptr, scr, r / 32, lane); }
    }
    const float* PQ = (const float*)(ws_ + WS_PQ) + (size_t)l * 32768;
    for (int it = gw; it < 8192; it += NGW) {
        const int k = it >> 3, part = (it >> 2) & 1, g = it & 3; const float* wr = win + (size_t)k * 2064 + g * 64; const float* pq = PQ + ((part * 4 + g) * 64) * 64 + lane; float acc = 0.f;
#pragma unroll 8
        for (int c = 0; c < 64; ++c) acc += wr[c] * pq[c * 64];
        W[W_IN + (size_t)(2048 + part * 256 + g * 64 + lane) * 1024 + k] = f2bf(acc * mixn[k]);
    }
    for (int i = obid() * 512 + tid; i < 131072; i += gridDim.x * 512) {
        const int k = i >> 7, n0 = (i & 127) * 8; const float gsc = mnx[k] * QSCALE_MEM; const f32x4 a = *(const f32x4*)(wq + (size_t)k * 1024 + n0), b = *(const f32x4*)(wq + (size_t)k * 1024 + n0 + 4);
        u32x4 w; w.x = cvt_pk_bf16(a[0] * gsc, a[1] * gsc); w.y = cvt_pk_bf16(a[2] * gsc, a[3] * gsc); w.z = cvt_pk_bf16(b[0] * gsc, b[1] * gsc); w.w = cvt_pk_bf16(b[2] * gsc, b[3] * gsc);
        *(u32x4*)(W + W_QB + (size_t)k * 1024 + n0) = w;
    }
}

__device__ __forceinline__ void phase_qkrope(const Params& p, int l, int S, int lgS) {
    unsigned char* const ws_ = ows(p);
    bf16_t* Z = (bf16_t*)(ws_ + WS_BIG + BG_Z); const float* qn = p.in[14] + l * 64; const float* kn = p.in[15] + l * 64;
    const int total = NTOK * 40; const int tid = otid(), lane = tid & 63;
    for (int i = obid() * 512 + tid; i < total; i += gridDim.x * 512) {
        const int row = i / 40, rem = i - row * 40, head = rem >> 2, sub = rem & 3, axis = sub >> 1, fg = sub & 1;
        const bool isq = head < 8; const int colb = isq ? head * 64 : 512 + (head - 8) * 64; const float* nw = isq ? qn : kn;
        bf16_t* p1 = Z + (size_t)row * 2048 + colb + axis * 32 + fg * 8; bf16_t* p2 = p1 + 16;
        const u32x4 w1 = *(const u32x4*)p1, w2 = *(const u32x4*)p2;
        float x1[8], x2[8];
#pragma unroll
        for (int e = 0; e < 4; ++e) { x1[2 * e] = bflo(w1[e]); x1[2 * e + 1] = bfhi(w1[e]); x2[2 * e] = bflo(w2[e]); x2[2 * e + 1] = bfhi(w2[e]); }
        float ss = 0.f;
#pragma unroll
        for (int e = 0; e < 8; ++e) ss += x1[e] * x1[e] + x2[e] * x2[e];
        ss += shx(ss, 1, lane); ss += shx(ss, 2, lane);
        const float rs = rsqrtf(ss * (1.0f / 64.0f) + 1e-6f) * (isq ? QSCALE_GQA : 1.0f);
        const int n = row & (S - 1); const float pos = (float)(axis == 0 ? (n >> 6) : (n & 63));
        float o1[8], o2[8];
#pragma unroll
        for (int e = 0; e < 8; ++e) {
            const int f = fg * 8 + e; const float inv = __builtin_amdgcn_exp2f(-(float)f * 0.8304820237218406f);
            const float rev = pos * inv * 0.15915494309189535f; const float c = __builtin_amdgcn_cosf(rev), s = __builtin_amdgcn_sinf(rev);
            const float a = x1[e] * rs * nw[axis * 32 + f], b = x2[e] * rs * nw[axis * 32 + 16 + f];
            o1[e] = a * c - b * s; o2[e] = b * c + a * s;
        }
        u32x4 r1, r2;
#pragma unroll
        for (int e = 0; e < 4; ++e) { r1[e] = cvt_pk_bf16(o1[2 * e], o1[2 * e + 1]); r2[e] = cvt_pk_bf16(o2[2 * e], o2[2 * e + 1]); }
        *(u32x4*)p1 = r1; *(u32x4*)p2 = r2;
    }
}

__device__ __forceinline__ void phase_dnprep(const Params& p, int l, int S, int lgS, int B, LAS unsigned char* lds) {
    unsigned char* const ws_ = ows(p);
    const int tid = otid(), lane = tid & 63, wid = __builtin_amdgcn_readfirstlane(tid >> 6), r32 = lane & 31, hi = lane >> 5;
    LAS float* qf = (LAS float*)lds; LAS float* kf = qf + 64 * 65; LAS float* vf = kf + 64 * 65; LAS float* G = vf + 64 * 65; LAS float* QK = G + 64 * 65;
    LAS float* Lm = QK + 64 * 65; LAS bf16_t* qh = (LAS bf16_t*)(Lm + 2 * 4096); LAS bf16_t* kh = qh + 64 * 72;
    LAS float* gs = (LAS float*)(kh + 64 * 72); LAS float* bs = gs + 128; LAS float* gc = bs + 128;
    const bf16_t* Z = (const bf16_t*)(ws_ + WS_BIG + BG_Z); const float* AB = (const float*)(ws_ + WS_AB);
    bf16_t* DN = (bf16_t*)(ws_ + WS_DN); float* GL = (float*)(ws_ + WS_GL);
    const float* conv = p.in[10] + (size_t)l * 3 * 768; const float* Alog = p.in[11] + l * 8; const float* dtb = p.in[12] + l * 8;
    const int Nc = S >> 6; const int nunits = NTOK / 64 * 4;
    for (int unit = obid(); unit < nunits; unit += gridDim.x) {
        const int h = unit & 3, gch = unit >> 2, b = gch >> (lgS - 6), n = gch & (Nc - 1), tok0 = gch * 64;
        {
            const int t = tid >> 3, s8 = tid & 7, row = tok0 + t, npos = n * 64 + t;
            const bf16_t* zr = Z + (size_t)row * 2048 + 768 + h * 64 + s8 * 8;
            float aq[8], ak[8], av[8];
#pragma unroll
            for (int e = 0; e < 8; ++e) { aq[e] = 0.f; ak[e] = 0.f; av[e] = 0.f; }
#pragma unroll
            for (int tap = 0; tap < 3; ++tap) {
                const int pp = npos + tap - 1;
                if (pp >= 0 && pp < S) {
                    const bf16_t* zz = zr + (tap - 1) * 2048; const u32x4 wq_ = *(const u32x4*)zz, wk_ = *(const u32x4*)(zz + 256), wv_ = *(const u32x4*)(zz + 512);
                    const float* cw = conv + tap * 768 + h * 64 + s8 * 8;
                    const f32x4 cq0 = *(const f32x4*)cw, cq1 = *(const f32x4*)(cw + 4), ck0 = *(const f32x4*)(cw + 256), ck1 = *(const f32x4*)(cw + 260), cv0 = *(const f32x4*)(cw + 512), cv1 = *(const f32x4*)(cw + 516);
#pragma unroll
                    for (int e = 0; e < 4; ++e) {
                        const float wq0 = e < 2 ? cq0[2 * e] : cq1[2 * e - 4], wq1 = e < 2 ? cq0[2 * e + 1] : cq1[2 * e - 3];
                        const float wk0 = e < 2 ? ck0[2 * e] : ck1[2 * e - 4], wk1 = e < 2 ? ck0[2 * e + 1] : ck1[2 * e - 3];
                        const float wv0 = e < 2 ? cv0[2 * e] : cv1[2 * e - 4], wv1 = e < 2 ? cv0[2 * e + 1] : cv1[2 * e - 3];
                        aq[2 * e] += bflo(wq_[e]) * wq0; aq[2 * e + 1] += bfhi(wq_[e]) * wq1;
                        ak[2 * e] += bflo(wk_[e]) * wk0; ak[2 * e + 1] += bfhi(wk_[e]) * wk1;
                        av[2 * e] += bflo(wv_[e]) * wv0; av[2 * e + 1] += bfhi(wv_[e]) * wv1;
                    }
                }
            }
            float sq = 0.f, sk = 0.f;
#pragma unroll
            for (int e = 0; e < 8; ++e) { aq[e] = aq[e] * __builtin_amdgcn_rcpf(1.0f + __expf(-aq[e])); ak[e] = ak[e] * __builtin_amdgcn_rcpf(1.0f + __expf(-ak[e])); av[e] = av[e] * __builtin_amdgcn_rcpf(1.0f + __expf(-av[e]));
                sq += aq[e] * aq[e]; sk += ak[e] * ak[e]; }
            sq += shx(sq, 1, lane); sq += shx(sq, 2, lane); sq += shx(sq, 4, lane);
            sk += shx(sk, 1, lane); sk += shx(sk, 2, lane); sk += shx(sk, 4, lane);
            const float rq = rsqrtf(sq + 1e-6f) * 0.125f, rk = rsqrtf(sk + 1e-6f);
#pragma unroll
            for (int e = 0; e < 8; ++e) { aq[e] *= rq; ak[e] *= rk; qf[t * 65 + s8 * 8 + e] = aq[e]; kf[t * 65 + s8 * 8 + e] = ak[e]; vf[t * 65 + s8 * 8 + e] = av[e]; }
            *(LAS bf16x8*)(qh + t * 72 + s8 * 8) = pack8(aq[0], aq[1], aq[2], aq[3], aq[4], aq[5], aq[6], aq[7]);
            *(LAS bf16x8*)(kh + t * 72 + s8 * 8) = pack8(ak[0], ak[1], ak[2], ak[3], ak[4], ak[5], ak[6], ak[7]);
            if (s8 < 2) {
                const int dir = s8; const float a = AB[(size_t)row * 16 + dir * 4 + h], bb = AB[(size_t)row * 16 + 8 + dir * 4 + h];
                const float xx = a + dtb[dir * 4 + h]; const float sp = xx > 20.f ? xx : log1pf(expf(xx));
                gs[dir * 64 + t] = -expf(Alog[dir * 4 + h]) * sp; bs[dir * 64 + t] = 1.0f / (1.0f + expf(-bb));
            }
        }
        __syncthreads();
        {
            const int mat = wid >> 2, ti = (wid >> 1) & 1, tj = wid & 1; const LAS bf16_t* am = mat ? qh : kh;
            f32x16 acc = {0.f, 0.f, 0.f, 0.f, 0.f, 0.f, 0.f, 0.f, 0.f, 0.f, 0.f, 0.f, 0.f, 0.f, 0.f, 0.f};
#pragma unroll
            for (int d0 = 0; d0 < 4; ++d0) { const bf16x8 a = *(const LAS bf16x8*)(am + (32 * ti + r32) * 72 + 16 * d0 + 8 * hi), bq = *(const LAS bf16x8*)(kh + (32 * tj + r32) * 72 + 16 * d0 + 8 * hi);
                acc = __builtin_amdgcn_mfma_f32_32x32x16_bf16(a, bq, acc, 0, 0, 0); }
            LAS float* M = mat ? QK : G;
#pragma unroll
            for (int r = 0; r < 16; ++r) M[(32 * ti + crow(r, hi)) * 65 + 32 * tj + r32] = acc[r];
            if (wid < 2) { const int dir = wid; float v = gs[dir * 64 + (dir ? 63 - lane : lane)];
#pragma unroll
                for (int o = 1; o < 64; o <<= 1) { const float tt = __int_as_float(__builtin_amdgcn_ds_bpermute(((lane - o) & 63) << 2, __float_as_int(v))); if (lane >= o) v += tt; }
                gc[dir * 64 + lane] = v; }
        }
        __syncthreads();
        const int m0 = n, m1 = Nc - 1 - n;
        bf16_t* dn0 = DN + ((((size_t)(b * 4 + h) * 2 + 0) * Nc + m0) * 20480); bf16_t* dn1 = DN + ((((size_t)(b * 4 + h) * 2 + 1) * Nc + m1) * 20480);
        {
            const int dir = tid >> 8, i = (tid >> 2) & 63, jq = tid & 3, ti_ = dir ? 63 - i : i; const float gci = gc[dir * 64 + i], bi = bs[dir * 64 + ti_];
            float qv[16];
#pragma unroll
            for (int e = 0; e < 16; ++e) { const int j = jq * 16 + e, tj_ = dir ? 63 - j : j; const float dec = (j <= i) ? __expf(gci - gc[dir * 64 + j]) : 0.f;
                Lm[dir * 4096 + i * 64 + j] = (j < i) ? bi * G[ti_ * 65 + tj_] * dec : 0.f; qv[pos16(e)] = QK[ti_ * 65 + tj_] * dec; }
            bf16_t* dst = (dir ? dn1 : dn0) + 2 * 4096 + i * 64 + jq * 16;
            *(bf16x8*)dst = pack8(qv[0], qv[1], qv[2], qv[3], qv[4], qv[5], qv[6], qv[7]); *(bf16x8*)(dst + 8) = pack8(qv[8], qv[9], qv[10], qv[11], qv[12], qv[13], qv[14], qv[15]);
        }
        __syncthreads();
        if (wid < 4) {
            const int dir = wid >> 1, half = wid & 1; const LAS float* src = half ? kf : vf; const LAS float* L = Lm + dir * 4096;
            float x[64]; const int rb_ = dir ? 63 : 0, rs_ = dir ? -1 : 1;
#pragma unroll
            for (int i = 0; i < 64; ++i) { const int ti_ = rb_ + rs_ * i; const float r = src[ti_ * 65 + lane] * bs[dir * 64 + ti_]; const float e = __expf(gc[dir * 64 + i]); x[i] = half ? r * e : r; }
#pragma unroll
            for (int i = 1; i < 64; ++i) { float s0 = x[i], s1 = 0.f, s2 = 0.f, s3 = 0.f; const LAS f32x4* Lr = (const LAS f32x4*)(L + i * 64);
#pragma unroll
                for (int j4 = 0; j4 < (i + 3) / 4; ++j4) { const f32x4 lv = Lr[j4]; s0 -= lv[0] * x[4 * j4]; s1 -= lv[1] * x[4 * j4 + 1]; s2 -= lv[2] * x[4 * j4 + 2]; s3 -= lv[3] * x[4 * j4 + 3]; }
                x[i] = (s0 + s1) + (s2 + s3); }
            bf16_t* dn = dir ? dn1 : dn0;
            if (half == 0) {
                const int ch = lane >> 5, nn = lane & 31;
#pragma unroll
                for (int T = 0; T < 2; ++T)
#pragma unroll
                    for (int hh = 0; hh < 2; ++hh) { bf16_t* d = dn + 4 * 4096 + ((ch * 2 + T) * 64 + hh * 32 + nn) * 16;
#define XR(r) x[32 * T + ((r) & 3) + 8 * ((r) >> 2) + 4 * hh]
                        *(bf16x8*)d = pack8(XR(0), XR(1), XR(2), XR(3), XR(4), XR(5), XR(6), XR(7)); *(bf16x8*)(d + 8) = pack8(XR(8), XR(9), XR(10), XR(11), XR(12), XR(13), XR(14), XR(15));
#undef XR
                    }
            } else {
                const int pc = (lane & ~15) + pos16(lane & 15);
#pragma unroll
                for (int i = 0; i < 64; ++i) dn[i * 64 + pc] = f2bf(-x[i]);
            }
        } else {
            const int dir = (wid >> 1) & 1, which = wid & 1; bf16_t* dn = dir ? dn1 : dn0;
            if (which == 0) { const int pc = (lane & ~15) + pos16(lane & 15);
#pragma unroll 8
                for (int i = 0; i < 64; ++i) { const int ti_ = dir ? 63 - i : i; dn[4096 + i * 64 + pc] = f2bf(qf[ti_ * 65 + lane] * __expf(gc[dir * 64 + i])); }
            } else { const int i = (lane & ~15) + pos16(lane & 15); const int ti_ = dir ? 63 - i : i; const float glast = gc[dir * 64 + 63]; const float sc = __expf(glast - gc[dir * 64 + i]);
#pragma unroll 8
                for (int d = 0; d < 64; ++d) dn[3 * 4096 + d * 64 + lane] = f2bf(kf[ti_ * 65 + d] * sc);
                if (lane == 0) GL[((size_t)(b * 4 + h) * 2 + dir) * Nc + (dir ? m1 : m0)] = __expf(glast); }
        }
        __syncthreads();
    }
}

__device__ __forceinline__ void phase_dnscan(const Params& p, int S, int lgS, int B) {
    unsigned char* const ws_ = ows(p);
    const int tid = otid(), lane = tid & 63, wid = __builtin_amdgcn_readfirstlane(tid >> 6), r32 = lane & 31, hi = lane >> 5;
    const int wk = wid * gridDim.x + obid(); if (wk >= B * 16) return;
    const int half = wk & 1, dir = (wk >> 1) & 1, h = (wk >> 2) & 3, b = wk >> 4; const int Nc = S >> 6;
    const bf16_t* DN = (const bf16_t*)(ws_ + WS_DN) + ((size_t)(b * 4 + h) * 2 + dir) * Nc * 20480; const float* GL = (const float*)(ws_ + WS_GL) + ((size_t)(b * 4 + h) * 2 + dir) * Nc;
    float* O2 = (float*)(ws_ + WS_X1) + (size_t)dir * NTOK * 256;
    f32x16 s0 = {0.f, 0.f, 0.f, 0.f, 0.f, 0.f, 0.f, 0.f, 0.f, 0.f, 0.f, 0.f, 0.f, 0.f, 0.f, 0.f}, s1 = s0;
    const f32x16 zero16 = s0;
    for (int m = 0; m < Nc; ++m) {
        const bf16_t* base = DN + (size_t)m * 20480; const float eg = GL[m];
        bf16x8 aw[2][4], aqd[2][4], aqk[2][4], akt[2][4]; u32x4 uu[2][2];
#pragma unroll
        for (int T = 0; T < 2; ++T) {
            const u32x4* up = (const u32x4*)(base + 4 * 4096 + ((half * 2 + T) * 64 + lane) * 16); uu[T][0] = up[0]; uu[T][1] = up[1];
#pragma unroll
            for (int kk = 0; kk < 4; ++kk) aw[T][kk] = *(const bf16x8*)(base + (32 * T + r32) * 64 + 16 * kk + 8 * hi);
        }
#pragma unroll
        for (int T = 0; T < 2; ++T)
#pragma unroll
            for (int kk = 0; kk < 4; ++kk) { aqd[T][kk] = *(const bf16x8*)(base + 4096 + (32 * T + r32) * 64 + 16 * kk + 8 * hi); aqk[T][kk] = *(const bf16x8*)(base + 2 * 4096 + (32 * T + r32) * 64 + 16 * kk + 8 * hi);
                akt[T][kk] = *(const bf16x8*)(base + 3 * 4096 + (32 * T + r32) * 64 + 16 * kk + 8 * hi); }
        asm volatile("" ::: "memory");
        bf16x8 sb[4];
        sb[0] = pack8(s0[0], s0[1], s0[2], s0[3], s0[4], s0[5], s0[6], s0[7]); sb[1] = pack8(s0[8], s0[9], s0[10], s0[11], s0[12], s0[13], s0[14], s0[15]);
        sb[2] = pack8(s1[0], s1[1], s1[2], s1[3], s1[4], s1[5], s1[6], s1[7]); sb[3] = pack8(s1[8], s1[9], s1[10], s1[11], s1[12], s1[13], s1[14], s1[15]);
        f32x16 vn[2];
#pragma unroll
        for (int T = 0; T < 2; ++T) {
            f32x16 c;
#pragma unroll
            for (int e = 0; e < 4; ++e) { c[2 * e] = bflo(uu[T][0][e]); c[2 * e + 1] = bfhi(uu[T][0][e]); c[8 + 2 * e] = bflo(uu[T][1][e]); c[9 + 2 * e] = bfhi(uu[T][1][e]); }
#pragma unroll
            for (int kk = 0; kk < 4; ++kk) c = __builtin_amdgcn_mfma_f32_32x32x16_bf16(aw[T][kk], sb[kk], c, 0, 0, 0);
            vn[T] = c;
        }
        bf16x8 vb[4];
        vb[0] = pack8(vn[0][0], vn[0][1], vn[0][2], vn[0][3], vn[0][4], vn[0][5], vn[0][6], vn[0][7]); vb[1] = pack8(vn[0][8], vn[0][9], vn[0][10], vn[0][11], vn[0][12], vn[0][13], vn[0][14], vn[0][15]);
        vb[2] = pack8(vn[1][0], vn[1][1], vn[1][2], vn[1][3], vn[1][4], vn[1][5], vn[1][6], vn[1][7]); vb[3] = pack8(vn[1][8], vn[1][9], vn[1][10], vn[1][11], vn[1][12], vn[1][13], vn[1][14], vn[1][15]);
        const int nchunk = dir ? Nc - 1 - m : m;
        int hi_ = hi; asm volatile("" : "+v"(hi_));
        float* orow = O2 + ((size_t)(b * S + nchunk * 64) * 256 + h * 64 + half * 32 + r32); const int rstep = dir ? -256 : 256; if (dir) orow += 63 * 256;
#pragma unroll
        for (int T = 0; T < 2; ++T) {
            f32x16 o = zero16;
#pragma unroll
            for (int kk = 0; kk < 4; ++kk) o = __builtin_amdgcn_mfma_f32_32x32x16_bf16(aqd[T][kk], sb[kk], o, 0, 0, 0);
#pragma unroll
            for (int kk = 0; kk < 4; ++kk) o = __builtin_amdgcn_mfma_f32_32x32x16_bf16(aqk[T][kk], vb[kk], o, 0, 0, 0);
#pragma unroll
            for (int r = 0; r < 16; ++r) { const int i = 32 * T + crow(r, hi_); orow[i * rstep] = o[r]; }
        }
        s0 = s0 * eg; s1 = s1 * eg;
#pragma unroll
        for (int kk = 0; kk < 4; ++kk) { s0 = __builtin_amdgcn_mfma_f32_32x32x16_bf16(akt[0][kk], vb[kk], s0, 0, 0, 0); s1 = __builtin_amdgcn_mfma_f32_32x32x16_bf16(akt[1][kk], vb[kk], s1, 0, 0, 0); }
    }
}

__device__ __forceinline__ void phase_dncombine(const Params& p, int l) {
    unsigned char* const ws_ = ows(p);
    const float* O2 = (const float*)(ws_ + WS_X1); const bf16_t* Z = (const bf16_t*)(ws_ + WS_BIG + BG_Z); bf16_t* YC = (bf16_t*)(ws_ + WS_YC); const float* on = p.in[13] + l * 64;
    const int total = NTOK * 32; const int tid = otid(), lane = tid & 63;
    for (int i = obid() * 512 + tid; i < total; i += gridDim.x * 512) {
        const int row = i >> 5, c0 = (i & 31) * 8;
        const f32x4 a0 = *(const f32x4*)(O2 + (size_t)row * 256 + c0), a1 = *(const f32x4*)(O2 + (size_t)row * 256 + c0 + 4);
        const f32x4 b0 = *(const f32x4*)(O2 + (size_t)(NTOK + row) * 256 + c0), b1 = *(const f32x4*)(O2 + (size_t)(NTOK + row) * 256 + c0 + 4);
        float o[8] = {a0[0] + b0[0], a0[1] + b0[1], a0[2] + b0[2], a0[3] + b0[3], a1[0] + b1[0], a1[1] + b1[1], a1[2] + b1[2], a1[3] + b1[3]};
        float ss = 0.f;
#pragma unroll
        for (int e = 0; e < 8; ++e) ss += o[e] * o[e];
        ss += shx(ss, 1, lane); ss += shx(ss, 2, lane); ss += shx(ss, 4, lane);
        const float rs = rsqrtf(ss * (1.0f / 64.0f) + 1e-6f);
        const u32x4 gw = *(const u32x4*)(Z + (size_t)row * 2048 + 1536 + c0);
        float r[8];
#pragma unroll
        for (int e = 0; e < 8; ++e) { const float g = (e & 1) ? bfhi(gw[e >> 1]) : bflo(gw[e >> 1]); r[e] = o[e] * rs * on[(c0 & 63) + e] * g * __builtin_amdgcn_rcpf(1.0f + __expf(-g)); }
        *(bf16x8*)(YC + (size_t)row * 1024 + 256 + c0) = pack8(r[0], r[1], r[2], r[3], r[4], r[5], r[6], r[7]);
    }
}

__device__ __forceinline__ void phase_attn(const Params& p, int S, int lgS, int B, int* counter, LAS unsigned char* lds) {
    unsigned char* const ws_ = ows(p);
    const int tid = otid(), lane = tid & 63, wid = __builtin_amdgcn_readfirstlane(tid >> 6), r32 = lane & 31, hi = lane >> 5;
    const bf16_t* Z = (const bf16_t*)(ws_ + WS_BIG + BG_Z); const bf16_t* VT = (const bf16_t*)(ws_ + WS_BIG + BG_VT); bf16_t* YC = (bf16_t*)(ws_ + WS_YC);
    constexpr int KB = 128 * 72 * 2, BUFB = KB + 64 * 136 * 2;
    const int nqt = S >> 8, lgq = lgS - 8, nunits = B * 8 * nqt, NT = S >> 7;
    LAS float* wsf = (LAS float*)(lds + 2 * BUFB + wid * 256);
    const int skey = tid >> 3, spc = tid & 7;
    const int kdst = (skey * 72 + spc * 8) * 2, vdst = KB + (skey * 136 + spc * 8) * 2;
    const int klane = (r32 * 72 + 8 * hi) * 2, vlane = (r32 * 136 + 4 * hi) * 2;
    const int G_ = (int)gridDim.x, bid_ = obid(), nscan = B * 16, per = nunits / G_;
    const bool deal = (nunits % G_ == 0) && (2 * nscan <= G_) && (per >= 2);
    const int nmine = !deal ? ((bid_ < nunits) ? (nunits - bid_ + G_ - 1) / G_ : 0) : (bid_ < nscan ? per - 1 : (bid_ < 2 * nscan ? per + 1 : per));
    for (int ui = 0; ui < nmine; ++ui) {
        const int unit = (deal && ui == per) ? (bid_ - nscan) + G_ * (per - 1) : bid_ + ui * G_;
        const int hq4 = unit & 3, qt = (unit >> 2) & (nqt - 1), bk = unit >> (2 + lgq), kvh = bk & 1, b = bk >> 1, qh = kvh * 4 + hq4;
        const size_t rowq = (size_t)b * S + qt * 256 + wid * 32 + r32;
        bf16x8 qr[4];
#pragma unroll
        for (int d0 = 0; d0 < 4; ++d0) qr[d0] = *(const bf16x8*)(Z + rowq * 2048 + qh * 64 + d0 * 16 + hi * 8);
        const bf16_t* ksrc = Z + ((size_t)b * S + skey) * 2048 + 512 + kvh * 64 + spc * 8;
        const bf16_t* vsrc = VT + (((size_t)(b * 128 + kvh * 64 + skey)) << lgS) + spc * 8;
        u32x4 kreg0 = *(const u32x4*)ksrc, kreg1 = *(const u32x4*)(ksrc + (size_t)64 * 2048), vreg0 = *(const u32x4*)vsrc, vreg1 = *(const u32x4*)(vsrc + 64);
        *(LAS u32x4*)(lds + kdst) = kreg0; *(LAS u32x4*)(lds + kdst + 64 * 144) = kreg1; *(LAS u32x4*)(lds + vdst) = vreg0; *(LAS u32x4*)(lds + vdst + 128) = vreg1;
        __syncthreads();
        float m_run = 0.f, l_run = 0.f;
        f32x16 o0 = {0.f, 0.f, 0.f, 0.f, 0.f, 0.f, 0.f, 0.f, 0.f, 0.f, 0.f, 0.f, 0.f, 0.f, 0.f, 0.f}, o1 = o0; const f32x16 zero16 = o0; f32x16 negm = o0;
        for (int t = 0; t < NT; ++t) {
            const LAS unsigned char* kb = lds + (t & 1) * BUFB; const LAS unsigned char* vb = kb + KB;
            if (t + 1 < NT) { const bf16_t* kn = ksrc + (size_t)(t + 1) * 128 * 2048; const bf16_t* vn_ = vsrc + (t + 1) * 128;
                kreg0 = *(const u32x4*)kn; kreg1 = *(const u32x4*)(kn + (size_t)64 * 2048); vreg0 = *(const u32x4*)vn_; vreg1 = *(const u32x4*)(vn_ + 64); }
            f32x16 pp[4] = {negm, negm, negm, negm};
            const LAS unsigned char* kl = kb + klane; const LAS unsigned char* vl = vb + vlane;
#pragma unroll
            for (int d0 = 0; d0 < 4; ++d0)
#pragma unroll
                for (int j = 0; j < 4; ++j) { const bf16x8 a = *(const LAS bf16x8*)(kl + (32 * j * 72 + 16 * d0) * 2); pp[j] = __builtin_amdgcn_mfma_f32_32x32x16_bf16(a, qr[d0], pp[j], 0, 0, 0); }
            float mxa = fmaxf(pp[0][0], pp[1][0]), mxb = fmaxf(pp[2][0], pp[3][0]);
#pragma unroll
            for (int r = 1; r < 16; ++r) { mxa = fmaxf(fmaxf(mxa, pp[0][r]), pp[1][r]); mxb = fmaxf(fmaxf(mxb, pp[2][r]), pp[3][r]); }
            float mx = fmaxf(mxa, mxb);
            mx = fmaxf(mx, shx(mx, 32, lane));
            const bool first = (t == 0);
            if (first || __any(mx > 8.f)) {
                const float d = first ? mx : fmaxf(mx, 0.f);
                m_run += d;
#pragma unroll
                for (int j = 0; j < 4; ++j)
#pragma unroll
                    for (int r = 0; r < 16; ++r) pp[j][r] -= d;
#pragma unroll
                for (int r = 0; r < 16; ++r) negm[r] = -m_run;
                if (!first) {
                    const float alpha = __builtin_amdgcn_exp2f(-d); l_run *= alpha;
                    if (hi == 0) wsf[r32] = alpha;
                    LDS_WAIT();
#pragma unroll
                    for (int r = 0; r < 16; ++r) { const float f = wsf[crow(r, hi)]; o0[r] *= f; o1[r] *= f; }
                    LDS_WAIT();
                }
            }
            float ls = 0.f;
#pragma unroll
            for (int j = 0; j < 4; ++j)
#pragma unroll
                for (int r = 0; r < 16; ++r) { pp[j][r] = __builtin_amdgcn_exp2f(pp[j][r]); ls += pp[j][r]; }
            l_run += ls;
#pragma unroll
            for (int j = 0; j < 4; ++j)
#pragma unroll
                for (int kk = 0; kk < 2; ++kk) {
                    const int ks = 2 * j + kk;
                    const bf16x8 pa = pack8(pp[j][8 * kk], pp[j][8 * kk + 1], pp[j][8 * kk + 2], pp[j][8 * kk + 3], pp[j][8 * kk + 4], pp[j][8 * kk + 5], pp[j][8 * kk + 6], pp[j][8 * kk + 7]);
                    const u32x2 v0a = *(const LAS u32x2*)(vl + (16 * ks) * 2), v0b = *(const LAS u32x2*)(vl + (16 * ks + 8) * 2);
                    const u32x2 v1a = *(const LAS u32x2*)(vl + (32 * 136 + 16 * ks) * 2), v1b = *(const LAS u32x2*)(vl + (32 * 136 + 16 * ks + 8) * 2);
                    const u32x4 f0 = {v0a.x, v0a.y, v0b.x, v0b.y}, f1 = {v1a.x, v1a.y, v1b.x, v1b.y};
                    o0 = __builtin_amdgcn_mfma_f32_32x32x16_bf16(pa, __builtin_bit_cast(bf16x8, f0), o0, 0, 0, 0);
                    o1 = __builtin_amdgcn_mfma_f32_32x32x16_bf16(pa, __builtin_bit_cast(bf16x8, f1), o1, 0, 0, 0);
                }
            if (t + 1 < NT) { LAS unsigned char* nb = lds + ((t + 1) & 1) * BUFB;
                *(LAS u32x4*)(nb + kdst) = kreg0; *(LAS u32x4*)(nb + kdst + 64 * 144) = kreg1; *(LAS u32x4*)(nb + vdst) = vreg0; *(LAS u32x4*)(nb + vdst + 128) = vreg1; }
            __syncthreads();
        }
        l_run += shx(l_run, 32, lane);
        if (hi == 0) wsf[32 + r32] = l_run;
        LDS_WAIT();
        bf16_t* orow = YC + ((size_t)b * S + qt * 256 + wid * 32) * 1024 + 512 + qh * 64;
#pragma unroll
        for (int r = 0; r < 16; ++r) { const int q = crow(r, hi); const float inv = 1.0f / wsf[32 + q];
            orow[(size_t)q * 1024 + r32] = f2bf(o0[r] * inv); orow[(size_t)q * 1024 + 32 + r32] = f2bf(o1[r] * inv); }
        LDS_WAIT();
    }
}

__device__ __forceinline__ void phase_final(const Params& p, float* X) {
    unsigned char* const ws_ = ows(p);
    const int tid = otid(), lane = tid & 63, wid = tid >> 6; const int gw = obid() * 8 + wid, NGW = gridDim.x * 8;
    const float* ssq = (const float*)(ws_ + WS_SSQ); const f32x4* fw = (const f32x4*)p.in[25] + lane;
    f32x4 w[4];
#pragma unroll
    for (int j = 0; j < 4; ++j) w[j] = fw[64 * j];
    for (int row = gw; row < NTOK; row += NGW) {
        const float rs = row_rstd(ssq, row); f32x4* xr = (f32x4*)(X + (size_t)row * 1024) + lane;
#pragma unroll
        for (int j = 0; j < 4; ++j) { const f32x4 v = xr[64 * j]; xr[64 * j] = v * rs * w[j]; }
    }
}

#define XB_TMO      128
#define XB_XCNT(j)  (256  + 64 * (j))
#define XB_XSUB(j)  (1280 + 64 * (j))
#define XB_XGEN(j)  (2304 + 64 * (j))
#define XB_TOP      3328
#define XB_TOPGEN   3392
#define XCD_BAR_WORDS 3456
#define XB_SPIN_CAP (1u << 22)
__device__ __forceinline__ unsigned xb_ld(unsigned* p)              { return __hip_atomic_load(p, __ATOMIC_RELAXED, __HIP_MEMORY_SCOPE_AGENT); }
__device__ __forceinline__ unsigned xb_add(unsigned* p, unsigned v) { return __hip_atomic_fetch_add(p, v, __ATOMIC_RELAXED, __HIP_MEMORY_SCOPE_AGENT); }
__device__ __forceinline__ unsigned xb_xcc_id() { return (unsigned)__builtin_amdgcn_s_getreg((3 << 11) | 20) & 0xFu; }
#define XB_SPIN(cond, bar) do { unsigned _sp = 0; while (cond) { __builtin_amdgcn_s_sleep(1); \
    if ((++_sp & 255u) == 0u) { if (xb_ld(&(bar)[XB_TMO])) break; if (_sp > XB_SPIN_CAP) { atomicAdd(&(bar)[XB_TMO], 1u); break; } } } } while (0)
__device__ __forceinline__ void xcd_barrier_complete(unsigned* bar, unsigned x, unsigned& nloc, unsigned& nx) {
    const unsigned G = gridDim.x * gridDim.y * gridDim.z;
    unsigned sum, cnt, mine, sp = 0u;
    for (;;) {
        sum = 0u; cnt = 0u; mine = 0u;
#pragma unroll
        for (unsigned j = 0; j < 16; ++j) { const unsigned c = xb_ld(&bar[XB_XCNT(j)]); sum += c; cnt += (c > 0u) ? 1u : 0u; mine = (j == x) ? c : mine; }
        if (sum == G) break;
        __builtin_amdgcn_s_sleep(1);
        if ((++sp & 255u) == 0u) { if (xb_ld(&bar[XB_TMO])) break; if (sp > XB_SPIN_CAP) { atomicAdd(&bar[XB_TMO], 1u); break; } }
    }
    nloc = mine > 0u ? mine : 1u; nx = cnt > 0u ? cnt : 1u;
}
__device__ __forceinline__ void xcd_barrier(unsigned* bar, volatile LAS unsigned* st) {
    asm volatile("s_waitcnt vmcnt(0) lgkmcnt(0)" ::: "memory");
    __syncthreads();
    if (threadIdx.x == 0) {
        __builtin_amdgcn_s_waitcnt(0);
        const unsigned x = xb_xcc_id();
        unsigned nloc = st[0], nx = st[1];
        if (nloc == 0u) { xcd_barrier_complete(bar, x, nloc, nx); st[0] = nloc; st[1] = nx; }
        const unsigned old = xb_add(&bar[XB_XSUB(x)], 1u);
        const unsigned gen = old / nloc;
        if (old + 1u == (gen + 1u) * nloc) {
            __builtin_amdgcn_fence(__ATOMIC_RELEASE, "agent");
            asm volatile("s_waitcnt vmcnt(0)" ::: "memory");
            const unsigned og = xb_add(&bar[XB_TOP], 1u);
            const unsigned tg = og / nx;
            if (og + 1u == (tg + 1u) * nx) xb_add(&bar[XB_TOPGEN], 1u);
            else XB_SPIN(xb_ld(&bar[XB_TOPGEN]) == tg, bar);
            __builtin_amdgcn_fence(__ATOMIC_ACQUIRE, "agent");
            xb_add(&bar[XB_XGEN(x)], 1u);
            asm volatile("s_waitcnt vmcnt(0)" ::: "memory");
        } else {
            XB_SPIN(xb_ld(&bar[XB_XGEN(x)]) == gen, bar);
            __builtin_amdgcn_fence(__ATOMIC_ACQUIRE, "agent");
            asm volatile("s_waitcnt vmcnt(0)" ::: "memory");
        }
    }
    __syncthreads();
}
#define GRID_SYNC() xcd_barrier((unsigned*)(p.ws + WS_CNT + 4096), (volatile LAS unsigned*)(lds + XB_LDS_OFF))
__global__ void __launch_bounds__(512, 2) mega_fwd(Params p) {
    extern __shared__ __attribute__((aligned(16))) unsigned char lds_raw[];
    LAS unsigned char* lds = (LAS unsigned char*)lds_raw;
    cg::grid_group grid = cg::this_grid();
    if (threadIdx.x < 4) ((LAS unsigned*)(lds + XB_LDS_OFF))[threadIdx.x] = 0u;
    __syncthreads();
    if (threadIdx.x == 0) (void)xb_add((unsigned*)(p.ws + WS_CNT + 4096) + XB_XCNT(xb_xcc_id()), 1u);
    grid.sync();
#ifdef PROBE_ZERO
    {
        u32x4* z = (u32x4*)p.ws; const size_t n = WS_END / 16; const u32x4 zz = {0u, 0u, 0u, 0u};
        for (size_t i = (size_t)blockIdx.x * 512 + threadIdx.x; i < n; i += (size_t)gridDim.x * 512) { if (i < WS_CNT / 16 || i >= (WS_CNT + 4096) / 16) z[i] = zz; }
        GRID_SYNC();
    }
#endif
    const int G = gridDim.x;
#define KW_PTRS unsigned char* const ws = ows(p); const int cid = obid(); bf16_t* const W = (bf16_t*)(ws + WS_W); bf16_t* const X1 = (bf16_t*)(ws + WS_X1); bf16_t* const YC = (bf16_t*)(ws + WS_YC); unsigned char* const BIG = ws + WS_BIG; \
    float* const ssq = (float*)(ws + WS_SSQ); const float* const mssq = (const float*)(ws + WS_MSSQ); (void)W; (void)X1; (void)YC; (void)BIG; (void)ssq; (void)mssq; (void)cid;
    for (int pass = 0; pass < 2; ++pass) {
        const int grp = 1 - pass; const int S = grp ? 8192 : 2048, lgS = grp ? 13 : 11, B = grp ? 8 : 32;
        float* X = p.out + (grp ? (size_t)67108864 : (size_t)0);
        bf16_t* DFT = grp ? (bf16_t*)p.out : (bf16_t*)(p.ws + WS_DFT2);
        if (PH(0)) phase_init(p, grp, S, lgS, B, X, DFT);
        for (int l = 0; l < 2; ++l) {
            if (l == 0) { if (PH(1)) { phase_pq(p, 0); phase_pq(p, 1); } GRID_SYNC(); }
            if (PH(2)) phase_weights(p, l, lds);
            GRID_SYNC();
            for (int rep = 0; rep < REP_SYNC; ++rep) { GRID_SYNC(); }
            for (int f = 0; f < 2; ++f) {
                if (f == 1) {
                    if (EN_MIX && PH(3)) { KW_PTRS pg8::Gemm g{X1, W + W_IN, 1024, 1024, 1024}; pg8::StaticOrder so; so.init(256, 10, G, cid);
                      pg8::EpiWin E{(bf16_t*)(BIG + BG_Z), (bf16_t*)(BIG + BG_FT), (bf16_t*)(BIG + BG_VT), (float*)(ws + WS_AB), ssq, S, lgS};
                      pg8::gemm_phase(lds, g, so, pg8::AddrStd{}, E); }
                    GRID_SYNC();
                    if (EN_MIX && EN_DFT && PH(8)) phase_fold(p, S, lgS, B, lds);
                    if (EN_MIX && EN_ATT && PH(4)) phase_qkrope(p, l, S, lgS);
                    for (int rep = 0; rep < REP_PREP; ++rep) { if (EN_MIX && EN_DN && PH(5)) phase_dnprep(p, l, S, lgS, B, lds); }
                    GRID_SYNC();
                    for (int rep = 0; rep < REP_SCAN; ++rep) { if (EN_MIX && EN_DN && PH(6)) phase_dnscan(p, S, lgS, B); }
                    __syncthreads();
                    for (int rep = 0; rep < REP_ATT; ++rep) { if (EN_MIX && EN_ATT && PH(7)) phase_attn(p, S, lgS, B, (int*)(p.ws + WS_CNT) + (pass * 2 + l) * 64, lds); __syncthreads(); }
                    if (EN_MIX && EN_DFT && PH(8)) { KW_PTRS pg8::Gemm g{DFT, (const bf16_t*)(BIG + BG_FT), S, S, 2 * S}; pg8::StaticOrder so; so.init(S >> 8, B, G, cid);
                      pg8::EpiBf16<2> E{YC, 1024, nullptr, rsqrtf((float)S * 64.0f), S};
                      pg8::gemm_phase(lds, g, so, pg8::AddrStd{}, E); }
                    GRID_SYNC();
                    if (EN_MIX && EN_DN && PH(9)) phase_dncombine(p, l);
                    if (EN_CROSS && PH(11)) { KW_PTRS pg8::Gemm g{(const bf16_t*)(ws + WS_MEMB), W + W_KV, 1024, 1024, 1024}; pg8::StaticOrder so; so.init(B, 8, G, cid);
                      pg8::EpiBf16<0> E{(bf16_t*)(BIG + BG_KV), 2048, mssq, 1.0f, S};
                      pg8::gemm_phase(lds, g, so, pg8::AddrStd{}, E); }
                    GRID_SYNC();
                    if (EN_MIX && PH(10)) { KW_PTRS pg8::Gemm g{YC, W + W_OUT, 1024, 1024, 1024}; pg8::StaticOrder so; so.init(256, 4, G, cid);
                      pg8::EpiRes E{X, X, X1, ssq, 1.0f};
                      pg8::gemm_phase(lds, g, so, pg8::AddrStd{}, E); }
                    if (EN_CROSS && PH(12)) { KW_PTRS pg8::Gemm g{(const bf16_t*)(BIG + BG_KV), W + W_QB, 256, 2048, 1024}; pg8::StaticOrder so; so.init(B * 4, 4, G, cid);
                      pg8::EpiBf16<0> E{(bf16_t*)(BIG + BG_WKT), 1024, nullptr, 1.0f, S};
                      pg8::gemm_phase(lds, g, so, pg8::AddrFoldK{}, E); }
                    if (EN_CROSS && PH(13)) { KW_PTRS pg8::Gemm g{W + W_OT, (const bf16_t*)(BIG + BG_KV), 256, 1024, 2048}; pg8::StaticOrder so; so.init(4, B * 4, G, cid);
                      pg8::EpiBf16<1> E{(bf16_t*)(BIG + BG_VWT), 1024, nullptr, 1.0f, S};
                      pg8::gemm_phase(lds, g, so, pg8::AddrFoldV{}, E); }
                    GRID_SYNC();
                    if (EN_CROSS && PH(14)) { KW_PTRS pg8::Gemm g{X1, (const bf16_t*)(BIG + BG_WKT), 1024, 1024, 1024}; pg8::StaticOrder so; so.init(256, 4, G, cid);
                      pg8::EpiSoftmax E{(bf16_t*)(BIG + BG_P), ssq};
                      pg8::gemm_phase(lds, g, so, pg8::AddrBatchB{lgS - 8}, E); }
                    GRID_SYNC();
                    if (EN_CROSS && PH(15)) { KW_PTRS pg8::Gemm g{(const bf16_t*)(BIG + BG_P), (const bf16_t*)(BIG + BG_VWT), 1024, 1024, 1024}; pg8::StaticOrder so; so.init(256, 4, G, cid);
                      pg8::EpiRes E{X, X, X1, ssq, 1.0f};
                      pg8::gemm_phase(lds, g, so, pg8::AddrBatchB{lgS - 8}, E); }
                    GRID_SYNC();
                }
                for (int rep = 0; rep < REP_GU; ++rep) if (EN_FFN && PH(16)) { KW_PTRS pg8::Gemm g{X1, W + (f ? W_GU2 : W_GU1), 1024, 1024, 1024}; pg8::StaticOrder so; so.init(256, 22, G, cid);
                  pg8::EpiSwiglu E{(bf16_t*)BIG, ssq};
                  pg8::gemm_phase(lds, g, so, pg8::AddrStd{}, E); }
                GRID_SYNC();
                if (EN_FFN && PH(17)) { KW_PTRS pg8::Gemm g{(const bf16_t*)BIG, W + (f ? W_D2 : W_D1), 2816, 2816, 2816}; pg8::StaticOrder so; so.init(256, 4, G, cid, 1);
                  pg8::EpiRes E{(l == 0 && f == 0) ? p.in[grp] : (const float*)X, X, (l == 1 && f == 1) ? (bf16_t*)nullptr : X1, ssq, 0.5f};
                  pg8::gemm_phase(lds, g, so, pg8::AddrStd{}, E); }
                GRID_SYNC();
            }
        }
        if (PH(18)) phase_final(p, X);
        GRID_SYNC();
    }
}

extern "C" void kernel_launch(void* const* d_in, const int* in_sizes, int n_in, void* d_out, int out_size, void* d_ws, size_t ws_size, hipStream_t stream) {
    static int grid = 0;
    if (grid == 0) {
        if (n_in != 26 || ws_size < WS_END) { fprintf(stderr, "kernel_launch: unexpected n_in %d / ws_size %zu\n", n_in, ws_size); grid = -1; return; }
        int dev = 0, cus = 0, per_cu = 0;
        hipGetDevice(&dev); hipDeviceGetAttribute(&cus, hipDeviceAttributeMultiprocessorCount, dev);
        hipFuncSetAttribute((const void*)mega_fwd, hipFuncAttributeMaxDynamicSharedMemorySize, LDS_BYTES);
        if (hipOccupancyMaxActiveBlocksPerMultiprocessor(&per_cu, (const void*)mega_fwd, 512, LDS_BYTES) != hipSuccess || per_cu < 1) per_cu = 1;
        (void)hipGetLastError();
        grid = cus * per_cu;
    }
    if (grid < 0) return;
    hipMemsetAsync((char*)d_ws + WS_CNT, 0, 32768, stream);
    Params p{};
    for (int i = 0; i < 26; ++i) p.in[i] = (const float*)d_in[i];
    p.out = (float*)d_out; p.ws = (unsigned char*)d_ws;
    void* args[] = {&p};
    hipError_t e = hipLaunchCooperativeKernel((const void*)mega_fwd, dim3(grid), dim3(512), args, LDS_BYTES, stream);
    if (e != hipSuccess) fprintf(stderr, "cooperative launch failed: %s (grid %d)\n", hipGetErrorString(e), grid);
}
```

```cpp
#define EN_MIX 1
#ifndef REP_SYNC
#define REP_SYNC 0
#endif
#ifndef REP_GU
#define REP_GU 1
#endif
#ifndef REP_PREP
#define REP_PREP 1
#endif
#ifndef REP_SCAN
#define REP_SCAN 1
#endif
#ifndef REP_ATT
#define REP_ATT 1
#endif
#define EN_DN 1
#define EN_ATT 1
#define EN_DFT 1
#define EN_CROSS 1
#define EN_FFN 1
#include <hip/hip_runtime.h>
#include <hip/hip_cooperative_groups.h>
#include <cstdio>
#include <cstdint>
namespace cg = cooperative_groups;

#define LAS __attribute__((address_space(3)))
typedef unsigned short bf16_t;
typedef short bf16x8 __attribute__((ext_vector_type(8)));
typedef float f32x4 __attribute__((ext_vector_type(4)));
typedef float f32x16 __attribute__((ext_vector_type(16)));
typedef unsigned u32x4 __attribute__((ext_vector_type(4)));
typedef unsigned u32x2 __attribute__((ext_vector_type(2)));

#define LDS_WAIT() asm volatile("s_waitcnt lgkmcnt(0)" ::: "memory")
#define LDS_BAR() asm volatile("s_waitcnt lgkmcnt(0)\n\ts_barrier" ::: "memory")

typedef float f32x2_t __attribute__((ext_vector_type(2))); typedef __bf16 bf16x2_t __attribute__((ext_vector_type(2)));
__device__ __forceinline__ unsigned cvt_pk_bf16(float lo, float hi) { const f32x2_t v = {lo, hi}; const bf16x2_t b = __builtin_convertvector(v, bf16x2_t); return __builtin_bit_cast(unsigned, b); }
__device__ __forceinline__ bf16_t f2bf(float f) { return (bf16_t)(cvt_pk_bf16(f, f) & 0xffffu); }
__device__ __forceinline__ float bf2f(unsigned h) { return __uint_as_float(h << 16); }
__device__ __forceinline__ float bflo(unsigned w) { return __uint_as_float(w << 16); }
__device__ __forceinline__ float bfhi(unsigned w) { return __uint_as_float(w & 0xffff0000u); }
__device__ __forceinline__ float shx(float v, int mask, int lane) { return __int_as_float(__builtin_amdgcn_ds_bpermute((lane ^ mask) << 2, __float_as_int(v))); }
__device__ __forceinline__ float wave_sum(float v, int lane) {
#pragma unroll
    for (int o = 1; o < 64; o <<= 1) v += shx(v, o, lane);
    return v;
}
__device__ __forceinline__ int otid() { int t = threadIdx.x; asm volatile("" : "+v"(t)); return t; }
__device__ __forceinline__ int obid() { int t = blockIdx.x; asm volatile("" : "+s"(t)); return t; }
__device__ __forceinline__ int crow(int r, int hi) { return (r & 3) + 8 * (r >> 2) + 4 * hi; }
__device__ __forceinline__ int pos16(int e) { return (((e >> 2) & 1) << 3) | (((e >> 3) & 1) << 2) | (e & 3); }
__device__ __forceinline__ bf16x8 pack8(float a0, float a1, float a2, float a3, float a4, float a5, float a6, float a7) {
    u32x4 w; w.x = cvt_pk_bf16(a0, a1); w.y = cvt_pk_bf16(a2, a3); w.z = cvt_pk_bf16(a4, a5); w.w = cvt_pk_bf16(a6, a7);
    return __builtin_bit_cast(bf16x8, w);
}
__device__ __forceinline__ float row_rstd(const float* ssq, int row) {
    const f32x4* p = (const f32x4*)(ssq + (size_t)row * 16);
    const f32x4 a = p[0], b = p[1], c = p[2], d = p[3];
    const float s = ((a.x + a.y) + (a.z + a.w)) + ((b.x + b.y) + (b.z + b.w)) + ((c.x + c.y) + (c.z + c.w)) + ((d.x + d.y) + (d.z + d.w));
    return rsqrtf(s * (1.0f / 1024.0f) + 1e-6f);
}

__device__ __forceinline__ void load_rstd8(const float* ssq, int row0, int fq, int lane, float (&rs)[8]) {
    f32x4 v[8];
#pragma unroll
    for (int g = 0; g < 8; ++g) v[g] = *(const f32x4*)(ssq + (size_t)(row0 + (g >> 2) * 128 + (g & 3) * 16) * 16 + fq * 4);
#pragma unroll
    for (int g = 0; g < 8; ++g) { float t = (v[g][0] + v[g][1]) + (v[g][2] + v[g][3]); t += shx(t, 16, lane); t += shx(t, 32, lane); rs[g] = rsqrtf(t * (1.0f / 1024.0f) + 1e-6f); }
}
namespace pg8 {
constexpr int BM = 256, BK = 64, HALF = 128, HTB = HALF * BK * 2, STAGE_BYTES = 8 * HTB, NXCD = 8, WGM = 8;
__host__ __device__ __forceinline__ int lds_byte(int r, int c) { const int st = (r >> 4) * 2 + (c >> 5), rr = r & 15, cc = c & 31, ob = rr * 64 + cc * 2; return st * 1024 + (ob ^ (((ob >> 9) & 1) << 5)); }
__host__ __device__ __forceinline__ void stage_rc(int b, int& R, int& C) { const int st = b / 1024, sb = b % 1024, swz = sb ^ (((sb >> 9) & 1) << 5); R = (st >> 1) * 16 + swz / 64; C = (st & 1) * 32 + (swz % 64) / 2; }
__host__ __device__ __forceinline__ int perm32(int rho) { const int n = rho >> 4, i = rho & 15; return 8 * (i >> 2) + 4 * n + (i & 3); }

struct Unit { int pm, pn; };
struct Gemm { const bf16_t* A; const bf16_t* Bt; int K, lda, ldb; };

struct StaticOrder {
    int nM, nN, nwg, G, c, rev;
    __device__ void init(int nM_, int nN_, int G_, int c_, int rev_ = 0) { nM = nM_; nN = nN_; nwg = nM * nN; G = G_; c = c_; rev = rev_; }
    __device__ bool next(int i, Unit& u) const {
        const long L = (long)i * G + c; if (L >= nwg) return false;
        int wgid = (int)L; { const int q = nwg / NXCD, r = nwg % NXCD, xcd = wgid % NXCD, off = wgid / NXCD; wgid = (xcd < r ? xcd * (q + 1) : r * (q + 1) + (xcd - r) * q) + off; }
        if (rev) wgid = nwg - 1 - wgid;
        const int nig = WGM * nN, gid = wgid / nig, fm = gid * WGM, gsz = (nM - fm) < WGM ? (nM - fm) : WGM;
        u.pm = fm + ((wgid % nig) % gsz); u.pn = (wgid % nig) / gsz; return true;
    }
};

struct AddrStd { __device__ __forceinline__ void get(const Gemm& g, const Unit& u, const char*& a, const char*& b) const {
    a = (const char*)g.A + (size_t)u.pm * 256 * g.lda * 2; b = (const char*)g.Bt + (size_t)u.pn * 256 * g.ldb * 2; } };
struct AddrBatchB { int lgtpb; __device__ __forceinline__ void get(const Gemm& g, const Unit& u, const char*& a, const char*& b) const {
    a = (const char*)g.A + (size_t)u.pm * 256 * g.lda * 2; b = (const char*)g.Bt + ((size_t)(u.pm >> lgtpb) * 1048576 + (size_t)u.pn * 256 * 1024) * 2; } };
struct AddrFoldK { __device__ __forceinline__ void get(const Gemm& g, const Unit& u, const char*& a, const char*& b) const {
    a = (const char*)g.A + ((size_t)(u.pm >> 2) * 256 * 2048 + (size_t)(u.pm & 3) * 256) * 2; b = (const char*)g.Bt + ((size_t)u.pn * 256 * 1024 + (size_t)(u.pm & 3) * 256) * 2; } };
struct AddrFoldV { __device__ __forceinline__ void get(const Gemm& g, const Unit& u, const char*& a, const char*& b) const {
    a = (const char*)g.A + ((size_t)u.pm * 256 * 1024 + (size_t)(u.pn & 3) * 256) * 2; b = (const char*)g.Bt + ((size_t)(u.pn >> 2) * 256 * 2048 + 1024 + (size_t)(u.pn & 3) * 256) * 2; } };

typedef f32x4 Acc[2][2][4][2];

struct EpiSwiglu {
    static constexpr bool PERM = true;
    bf16_t* H; const float* ssq;
    __device__ __forceinline__ void operator()(Acc& acc, const Unit& u, int wr, int wc, int fr, int fq, LAS unsigned char* xch) const {
        const int row0 = u.pm * 256 + wr * 64 + fr, col0 = u.pn * 128 + wc * 32 + 8 * fq;
        float rs8[8]; load_rstd8(ssq, row0, fq, fq * 16 + fr, rs8);
#pragma unroll
        for (int ai = 0; ai < 2; ++ai)
#pragma unroll
            for (int m = 0; m < 4; ++m) {
                const int row = row0 + ai * 128 + m * 16; const float rs = rs8[ai * 4 + m];
                float hv[8];
#pragma unroll
                for (int n = 0; n < 2; ++n)
#pragma unroll
                    for (int j = 0; j < 4; ++j) { const float g = acc[ai][0][m][n][j] * rs, uu = acc[ai][1][m][n][j] * rs;
                        hv[n * 4 + j] = g * __builtin_amdgcn_rcpf(1.0f + __expf(-g)) * uu; }
                u32x4 w; w.x = cvt_pk_bf16(hv[0], hv[1]); w.y = cvt_pk_bf16(hv[2], hv[3]); w.z = cvt_pk_bf16(hv[4], hv[5]); w.w = cvt_pk_bf16(hv[6], hv[7]);
                *(u32x4*)(H + (size_t)row * 2816 + col0) = w; asm volatile("" ::: "memory");
            }
    }
};
struct EpiRes {
    static constexpr bool PERM = false; static constexpr int PD = 3;
    const float* Xb; float* X; bf16_t* XB; float* ssq; float alpha;
    __device__ __forceinline__ void operator()(Acc& acc, const Unit& u, int wr, int wc, int fr, int fq, LAS unsigned char* xch) const {
        const int row0 = u.pm * 256 + wr * 64 + fr, col0 = u.pn * 256 + wc * 32 + 4 * fq;
        f32x4 pre[PD][4];
#pragma unroll
        for (int g = 0; g < PD; ++g) { const float* xr = Xb + (size_t)(row0 + (g >> 2) * 128 + (g & 3) * 16) * 1024 + col0;
#pragma unroll
            for (int q = 0; q < 4; ++q) pre[g][q] = *(const f32x4*)(xr + (q >> 1) * 128 + (q & 1) * 16); }
#pragma unroll
        for (int g = 0; g < 8; ++g) {
            const int ai = g >> 2, m = g & 3; const int row = row0 + ai * 128 + m * 16; float s = 0.f;
            float* xr = X + (size_t)row * 1024 + col0; bf16_t* br = XB + (size_t)row * 1024 + col0;
            f32x4 v[4];
#pragma unroll
            for (int q = 0; q < 4; ++q) v[q] = pre[g % PD][q] + acc[ai][q >> 1][m][q & 1] * alpha;
            if (g + PD < 8) { const int gn = g + PD; const float* xn = Xb + (size_t)(row0 + (gn >> 2) * 128 + (gn & 3) * 16) * 1024 + col0;
#pragma unroll
                for (int q = 0; q < 4; ++q) pre[g % PD][q] = *(const f32x4*)(xn + (q >> 1) * 128 + (q & 1) * 16); }
#pragma unroll
            for (int q = 0; q < 4; ++q) {
                *(f32x4*)(xr + (q >> 1) * 128 + (q & 1) * 16) = v[q];
                if (XB) { u32x2 w; w.x = cvt_pk_bf16(v[q][0], v[q][1]); w.y = cvt_pk_bf16(v[q][2], v[q][3]); *(u32x2*)(br + (q >> 1) * 128 + (q & 1) * 16) = w; }
                s += (v[q][0] * v[q][0] + v[q][1] * v[q][1]) + (v[q][2] * v[q][2] + v[q][3] * v[q][3]);
            }
            s += shx(s, 16, fq * 16 + fr); s += shx(s, 32, fq * 16 + fr);
            if (fq == 0) ssq[(size_t)row * 16 + u.pn * 4 + wc] = s;
            asm volatile("" ::: "memory");
        }
    }
};
template <int MODE> struct EpiBf16 {
    static constexpr bool PERM = true;
    bf16_t* O; int ld; const float* ssq; float scale; int S;
    __device__ __forceinline__ void operator()(Acc& acc, const Unit& u, int wr, int wc, int fr, int fq, LAS unsigned char* xch) const {
        int rowb, colb;
        if (MODE == 0) { rowb = u.pm * 256; colb = u.pn * 256; } else if (MODE == 1) { rowb = (u.pn >> 2) * 1024 + u.pm * 256; colb = (u.pn & 3) * 256; } else { rowb = u.pn * S + u.pm * 256; colb = 0; }
        const int rl0 = wr * 64 + fr, col0 = colb + wc * 32 + 8 * fq;
        float rs8[8];
        if (ssq) load_rstd8(ssq, u.pm * 256 + rl0, fq, fq * 16 + fr, rs8);
#pragma unroll
        for (int ai = 0; ai < 2; ++ai)
#pragma unroll
            for (int m = 0; m < 4; ++m) {
                const int rl = rl0 + ai * 128 + m * 16; float rs = scale; if (ssq) rs *= rs8[ai * 4 + m];
                bf16_t* rowp = O + (size_t)(rowb + rl) * ld + col0;
#pragma unroll
                for (int bj = 0; bj < 2; ++bj) { const f32x4 v0 = acc[ai][bj][m][0] * rs, v1 = acc[ai][bj][m][1] * rs;
                    u32x4 w; w.x = cvt_pk_bf16(v0[0], v0[1]); w.y = cvt_pk_bf16(v0[2], v0[3]); w.z = cvt_pk_bf16(v1[0], v1[1]); w.w = cvt_pk_bf16(v1[2], v1[3]);
                    *(u32x4*)(rowp + bj * 128) = w; } asm volatile("" ::: "memory");
            }
    }
};
struct EpiWin {
    static constexpr bool PERM = true;
    bf16_t* Z; bf16_t* FT; bf16_t* VT; float* AB; const float* ssq; int S, lgS;
    __device__ __forceinline__ void operator()(Acc& acc, const Unit& u, int wr, int wc, int fr, int fq, LAS unsigned char* xch) const {
        const int pn = u.pn; const int row0 = u.pm * 256 + wr * 64 + fr;
        float rs8[8]; load_rstd8(ssq, row0, fq, fq * 16 + fr, rs8);
#pragma unroll
        for (int ai = 0; ai < 2; ++ai)
#pragma unroll
            for (int m = 0; m < 4; ++m) {
                const int row = row0 + ai * 128 + m * 16; const float rs = rs8[ai * 4 + m];
                const int b = row >> lgS, nloc = row & (S - 1);
#pragma unroll
                for (int bj = 0; bj < 2; ++bj) {
                    const f32x4 v0 = acc[ai][bj][m][0] * rs, v1 = acc[ai][bj][m][1] * rs; const int cl = bj * 128 + wc * 32 + 8 * fq;
                    const float vv[8] = {v0[0], v0[1], v0[2], v0[3], v1[0], v1[1], v1[2], v1[3]};
                    if (pn < 7 && !(pn == 2 && bj == 1)) {
                        u32x4 w; w.x = cvt_pk_bf16(vv[0], vv[1]); w.y = cvt_pk_bf16(vv[2], vv[3]); w.z = cvt_pk_bf16(vv[4], vv[5]); w.w = cvt_pk_bf16(vv[6], vv[7]);
                        *(u32x4*)(Z + (size_t)row * 2048 + pn * 256 + cl) = w;
                    } else if (pn == 2) {
                        const int cv = cl - 128;
#pragma unroll
                        for (int e = 0; e < 8; ++e) VT[((size_t)(b * 128 + cv + e) << lgS) + nloc] = f2bf(vv[e]);
                    } else if (pn == 7) {
                        if (cl < 16) { *(f32x4*)(AB + (size_t)row * 16 + cl) = v0; *(f32x4*)(AB + (size_t)row * 16 + cl + 4) = v1; }
                    } else {
                        const int part = pn - 8;
#pragma unroll
                        for (int e = 0; e < 8; ++e) FT[((size_t)(b * 256 + cl + e) << (lgS + 1)) + ((size_t)part << lgS) + nloc] = f2bf(vv[e]);
                    }
                } asm volatile("" ::: "memory");
            }
    }
};
struct EpiSoftmax {
    static constexpr bool PERM = true;
    bf16_t* P; const float* ssq;
    __device__ __forceinline__ void operator()(Acc& acc, const Unit& u, int wr, int wc, int fr, int fq, LAS unsigned char* xch) const {
        LAS float* xm = (LAS float*)xch; LAS float* xs = xm + 1024;
        const int rl0 = wr * 64 + fr;
        float rs8[8]; load_rstd8(ssq, u.pm * 256 + rl0, fq, fq * 16 + fr, rs8);
#pragma unroll
        for (int ai = 0; ai < 2; ++ai)
#pragma unroll
            for (int m = 0; m < 4; ++m) {
                const int rl = rl0 + ai * 128 + m * 16; const float rs = rs8[ai * 4 + m]; float mx = -INFINITY;
#pragma unroll
                for (int bj = 0; bj < 2; ++bj)
#pragma unroll
                    for (int n = 0; n < 2; ++n) { const f32x4 v = acc[ai][bj][m][n] * rs; acc[ai][bj][m][n] = v; mx = fmaxf(mx, fmaxf(fmaxf(v[0], v[1]), fmaxf(v[2], v[3]))); }
                mx = fmaxf(mx, shx(mx, 16, fq * 16 + fr)); mx = fmaxf(mx, shx(mx, 32, fq * 16 + fr));
                if (fq == 0) xm[rl * 4 + wc] = mx; asm volatile("" ::: "memory");
            }
        LDS_BAR();
#pragma unroll
        for (int ai = 0; ai < 2; ++ai)
#pragma unroll
            for (int m = 0; m < 4; ++m) {
                const int rl = rl0 + ai * 128 + m * 16; const f32x4 q = *(LAS f32x4*)(xm + rl * 4);
                const float mx = fmaxf(fmaxf(q[0], q[1]), fmaxf(q[2], q[3])); float s = 0.f;
#pragma unroll
                for (int bj = 0; bj < 2; ++bj)
#pragma unroll
                    for (int n = 0; n < 2; ++n) { f32x4 v = acc[ai][bj][m][n];
#pragma unroll
                        for (int j = 0; j < 4; ++j) v[j] = __builtin_amdgcn_exp2f(v[j] - mx);
                        acc[ai][bj][m][n] = v; s += (v[0] + v[1]) + (v[2] + v[3]); }
                s += shx(s, 16, fq * 16 + fr); s += shx(s, 32, fq * 16 + fr);
                if (fq == 0) xs[rl * 4 + wc] = s; asm volatile("" ::: "memory");
            }
        LDS_BAR();
        const int col0 = u.pn * 256 + wc * 32 + 8 * fq;
#pragma unroll
        for (int ai = 0; ai < 2; ++ai)
#pragma unroll
            for (int m = 0; m < 4; ++m) {
                const int rl = rl0 + ai * 128 + m * 16; const f32x4 q = *(LAS f32x4*)(xs + rl * 4);
                const float inv = 1.0f / ((q[0] + q[1]) + (q[2] + q[3]));
                bf16_t* rowp = P + (size_t)(u.pm * 256 + rl) * 1024 + col0;
#pragma unroll
                for (int bj = 0; bj < 2; ++bj) { const f32x4 v0 = acc[ai][bj][m][0] * inv, v1 = acc[ai][bj][m][1] * inv;
                    u32x4 w; w.x = cvt_pk_bf16(v0[0], v0[1]); w.y = cvt_pk_bf16(v0[2], v0[3]); w.z = cvt_pk_bf16(v1[0], v1[1]); w.w = cvt_pk_bf16(v1[2], v1[3]);
                    *(u32x4*)(rowp + bj * 128) = w; } asm volatile("" ::: "memory");
            }
    }
};

template <class Epi, class Addr>
__device__ __forceinline__ void gemm_phase(LAS unsigned char* lds, const Gemm g, const StaticOrder& S, const Addr& AD, const Epi& E) {
    const int tid = otid(), wid = __builtin_amdgcn_readfirstlane(tid >> 6), lane = tid & 63, wr = wid >> 2, wc = wid & 3, fr = lane & 15, fq = lane >> 4;
    int Kq = g.K; asm volatile("" : "+s"(Kq));
    const int nt = Kq / BK;
    unsigned voffA[2], voffB[2];
#pragma unroll
    for (int i = 0; i < 2; ++i) { int R, C; stage_rc(tid * 16 + i * 8192, R, C); const int Rb = Epi::PERM ? ((R & ~31) + perm32(R & 31)) : R;
        voffA[i] = (unsigned)(R * g.lda + C) * 2u; voffB[i] = (unsigned)(Rb * g.ldb + C) * 2u; }
    const size_t kstep = (size_t)(BK * 2);
    const size_t hstepA = (size_t)HALF * g.lda * 2, hstepB = (size_t)HALF * g.ldb * 2;
    const unsigned ldsw = (unsigned)wid * 1024u;
    const int aoff = lds_byte(wr * 64 + fr, fq * 8), boff = lds_byte(wc * 32 + fr, fq * 8);
    LAS unsigned char* xch = lds + STAGE_BYTES;
#define PG8_SA(b, h) (((b) * 2 + (h)) * HTB)
#define PG8_SB(b, h) ((4 + (b) * 2 + (h)) * HTB)
#define PG8_STAGE(bufoff, gbase, voff) do { _Pragma("unroll") for (int _i = 0; _i < 2; ++_i) \
        __builtin_amdgcn_global_load_lds((const unsigned*)((const char*)(gbase) + (voff)[_i]), (LAS unsigned*)(lds + (bufoff) + ldsw + _i * 8192), 16, 0, 0); } while (0)
#define PG8_LDA(dst, b, h) do { _Pragma("unroll") for (int m = 0; m < 4; ++m) _Pragma("unroll") for (int k = 0; k < 2; ++k) dst[m][k] = *(const LAS bf16x8*)(lds + PG8_SA(b, h) + aoff + m * 2048 + k * 1024); } while (0)
#define PG8_LDB(dst, b, h) do { _Pragma("unroll") for (int n = 0; n < 2; ++n) _Pragma("unroll") for (int k = 0; k < 2; ++k) dst[n][k] = *(const LAS bf16x8*)(lds + PG8_SB(b, h) + boff + n * 2048 + k * 1024); } while (0)
#define PG8_MMA(ai, bj, At, Bt) do { __builtin_amdgcn_s_setprio(1); _Pragma("unroll") for (int m = 0; m < 4; ++m) _Pragma("unroll") for (int n = 0; n < 2; ++n) _Pragma("unroll") for (int k = 0; k < 2; ++k) \
        acc[ai][bj][m][n] = __builtin_amdgcn_mfma_f32_16x16x32_bf16(Bt[n][k], At[m][k], acc[ai][bj][m][n], 0, 0, 0); __builtin_amdgcn_s_setprio(0); } while (0)
#define PG8_WAIT_V(n) asm volatile("s_waitcnt vmcnt(" #n ")" ::: "memory")
#define PG8_WAIT_L(n) asm volatile("s_waitcnt lgkmcnt(" #n ")" ::: "memory")
#define PG8_BAR __builtin_amdgcn_s_barrier()
#define PG8_SCHED __builtin_amdgcn_sched_barrier(0)
    Unit cur, nxt; int ui = 0;
    if (!S.next(0, cur)) return;
    Acc acc;
#pragma unroll
    for (int a = 0; a < 2; ++a)
#pragma unroll
        for (int b = 0; b < 2; ++b)
#pragma unroll
            for (int m = 0; m < 4; ++m)
#pragma unroll
                for (int n = 0; n < 2; ++n) acc[a][b][m][n] = (f32x4){0.f, 0.f, 0.f, 0.f};
    bf16x8 At[4][2], B0[2][2], B1[2][2];
    const char* cA; const char* cB; AD.get(g, cur, cA, cB);
    PG8_STAGE(PG8_SB(0, 0), cB, voffB); PG8_STAGE(PG8_SB(0, 1), cB + hstepB, voffB); PG8_STAGE(PG8_SA(0, 0), cA, voffA); PG8_STAGE(PG8_SA(0, 1), cA + hstepA, voffA);
    if (wr == 1) PG8_BAR;
    PG8_WAIT_V(2); PG8_BAR;
    PG8_STAGE(PG8_SB(1, 0), cB + kstep, voffB); PG8_STAGE(PG8_SA(1, 0), cA + kstep, voffA); PG8_STAGE(PG8_SB(1, 1), cB + hstepB + kstep, voffB);
    PG8_WAIT_V(6); PG8_BAR;
    for (;;) {
        const bool has_next = S.next(ui + 1, nxt);
        const char* nA = cA; const char* nB = cB; if (has_next) AD.get(g, nxt, nA, nB);
        for (int t = 0; t < nt; t += 2) {
            const bool last = (t == nt - 2);
            const char* a1 = cA + (size_t)(t + 1) * kstep;
            const char* a2 = last ? nA : cA + (size_t)(t + 2) * kstep; const char* b2 = last ? nB : cB + (size_t)(t + 2) * kstep;
            const char* a3 = a2 + kstep; const char* b3 = b2 + kstep;
            PG8_LDB(B0, 0, 0); PG8_LDB(B1, 0, 1); PG8_SCHED; PG8_LDA(At, 0, 0); PG8_STAGE(PG8_SA(1, 1), a1 + hstepA, voffA);
            PG8_WAIT_V(8); PG8_WAIT_L(0); PG8_BAR; PG8_MMA(0, 0, At, B0); PG8_MMA(0, 1, At, B1); PG8_BAR; PG8_SCHED;
            PG8_LDA(At, 0, 1); PG8_STAGE(PG8_SB(0, 0), b2, voffB); PG8_STAGE(PG8_SB(0, 1), b2 + hstepB, voffB); PG8_STAGE(PG8_SA(0, 0), a2, voffA);
            PG8_WAIT_V(8); PG8_WAIT_L(0); PG8_BAR; PG8_MMA(1, 0, At, B0); PG8_MMA(1, 1, At, B1); PG8_BAR; PG8_SCHED;
            PG8_LDB(B0, 1, 0); PG8_LDB(B1, 1, 1); PG8_SCHED; PG8_LDA(At, 1, 0); PG8_STAGE(PG8_SA(0, 1), a2 + hstepA, voffA);
            PG8_WAIT_V(8); PG8_WAIT_L(0); PG8_BAR; PG8_MMA(0, 0, At, B0); PG8_MMA(0, 1, At, B1); PG8_BAR; PG8_SCHED;
            PG8_LDA(At, 1, 1); PG8_STAGE(PG8_SB(1, 0), b3, voffB); PG8_STAGE(PG8_SB(1, 1), b3 + hstepB, voffB); PG8_STAGE(PG8_SA(1, 0), a3, voffA);
            PG8_WAIT_V(8); PG8_WAIT_L(0); PG8_BAR; PG8_MMA(1, 0, At, B0); PG8_MMA(1, 1, At, B1); PG8_BAR; PG8_SCHED;
        }
        if (wr == 0) PG8_BAR;
        { int fr_ = fr, fq_ = fq; asm volatile("" : "+v"(fr_), "+v"(fq_));
          E(acc, cur, wr, wc, fr_, fq_, xch); }
        if (!has_next) break;
#pragma unroll
        for (int a = 0; a < 2; ++a)
#pragma unroll
            for (int b = 0; b < 2; ++b)
#pragma unroll
                for (int m = 0; m < 4; ++m)
#pragma unroll
                    for (int n = 0; n < 2; ++n) acc[a][b][m][n] = (f32x4){0.f, 0.f, 0.f, 0.f};
        cur = nxt; cA = nA; cB = nB; ++ui;
        if (wr == 1) PG8_BAR;
    }
    PG8_WAIT_V(0);
    PG8_BAR;
#undef PG8_SA
#undef PG8_SB
#undef PG8_STAGE
#undef PG8_LDA
#undef PG8_LDB
#undef PG8_MMA
#undef PG8_WAIT_V
#undef PG8_WAIT_L
#undef PG8_BAR
#undef PG8_SCHED
}
}

constexpr int NTOK = 65536;
constexpr size_t MiB = 1u << 20;
constexpr size_t WS_SSQ = 0, WS_MSSQ = 4 * MiB, WS_PQ = 5 * MiB, WS_GL = 5 * MiB + 512 * 1024, WS_CNT = 6 * MiB;
constexpr size_t WS_W = 8 * MiB, WS_X1 = 56 * MiB, WS_YC = 184 * MiB, WS_BIG = 312 * MiB, WS_DN = 664 * MiB, WS_DFT2 = 984 * MiB, WS_MEMB = 1000 * MiB, WS_AB = 1016 * MiB, WS_END = 1020 * MiB;
constexpr size_t BG_Z = 0, BG_FT = 256 * MiB, BG_VT = 320 * MiB;
constexpr size_t BG_P = 0, BG_WKT = 128 * MiB, BG_VWT = 192 * MiB, BG_KV = 256 * MiB;
constexpr size_t W_GU1 = 0, W_D1 = 5767168, W_IN = 8650752, W_OUT = 11272192, W_QB = 12320768, W_KV = 13369344, W_OT = 15466496, W_GU2 = 16515072, W_D2 = 22282240;
#ifndef PHASE_SEL
#define PHASE_SEL -1
#endif
#define PH(n) (PHASE_SEL < 0 || PHASE_SEL == (n))
constexpr int LDS_BYTES = 147456;
constexpr int XCH_OFF = 131072, CNT_OFF = 140000, XB_LDS_OFF = 143360;
constexpr float QSCALE_GQA = 0.125f * 1.4426950408889634f;
constexpr float QSCALE_MEM = 0.0625f * 1.4426950408889634f;

struct Params { const float* in[26]; float* out; unsigned char* ws; };
typedef __attribute__((address_space(1))) unsigned char gu8_t;
__device__ __forceinline__ unsigned char* ows(const Params& p) { gu8_t* w = (gu8_t*)p.ws; asm volatile("" : "+s"(w)); return (unsigned char*)w; }

__device__ __forceinline__ void phase_init(const Params& p, int grp, int S, int lgS, int B, float* X, bf16_t* DFT) {
    unsigned char* const ws_ = ows(p);
    const int tid = otid(), lane = tid & 63, wid = tid >> 6;
    const int gw = obid() * 8 + wid, NGW = gridDim.x * 8;
    unsigned char* ws = ws_;
    const float* xin = p.in[grp]; bf16_t* X1 = (bf16_t*)(ws + WS_X1); float* ssq = (float*)(ws + WS_SSQ);
    for (int row = gw; row < NTOK; row += NGW) {
        const f32x4* xr = (const f32x4*)(xin + (size_t)row * 1024) + lane; f32x4 v[4]; float s = 0.f;
#pragma unroll
        for (int j = 0; j < 4; ++j) { v[j] = xr[64 * j]; s += (v[j][0] * v[j][0] + v[j][1] * v[j][1]) + (v[j][2] * v[j][2] + v[j][3] * v[j][3]); }
        s = wave_sum(s, lane);
        u32x2* ob = (u32x2*)(X1 + (size_t)row * 1024) + lane;
#pragma unroll
        for (int j = 0; j < 4; ++j) { u32x2 w; w.x = cvt_pk_bf16(v[j][0], v[j][1]); w.y = cvt_pk_bf16(v[j][2], v[j][3]); ob[64 * j] = w; }
        if (lane < 16) ssq[(size_t)row * 16 + lane] = (lane == 0) ? s : 0.f;
    }
    const float* memin = p.in[2 + grp]; bf16_t* MB = (bf16_t*)(ws + WS_MEMB); float* mssq = (float*)(ws + WS_MSSQ);
    for (int row = gw; row < B * 256; row += NGW) {
        const f32x4* xr = (const f32x4*)(memin + (size_t)row * 1024) + lane; f32x4 v[4]; float s = 0.f;
#pragma unroll
        for (int j = 0; j < 4; ++j) { v[j] = xr[64 * j]; s += (v[j][0] * v[j][0] + v[j][1] * v[j][1]) + (v[j][2] * v[j][2] + v[j][3] * v[j][3]); }
        s = wave_sum(s, lane);
        u32x2* ob = (u32x2*)(MB + (size_t)row * 1024) + lane;
#pragma unroll
        for (int j = 0; j < 4; ++j) { u32x2 w; w.x = cvt_pk_bf16(v[j][0], v[j][1]); w.y = cvt_pk_bf16(v[j][2], v[j][3]); ob[64 * j] = w; }
        if (lane < 16) mssq[(size_t)row * 16 + lane] = (lane == 0) ? s : 0.f;
    }
    const size_t nvec = ((size_t)S * (size_t)S) >> 3; const size_t NT = (size_t)gridDim.x * 512;
    const float invS = 1.0f / (float)S; const int hS = S >> 1;
    for (size_t i = (size_t)obid() * 512 + tid; i < nvec; i += NT) {
        const int j = (int)(i >> (lgS - 3)); const int c0 = (int)(i & (size_t)((S >> 3) - 1)) * 8;
        float v[8];
#pragma unroll
        for (int e = 0; e < 8; ++e) { const int k = c0 + e; const bool sn = k > hS; const int kk = sn ? k - hS : k; const int idx = (j * kk) & (S - 1); const float fr = (float)idx * invS;
            v[e] = sn ? -__builtin_amdgcn_sinf(fr) : __builtin_amdgcn_cosf(fr); }
        u32x4 w; w.x = cvt_pk_bf16(v[0], v[1]); w.y = cvt_pk_bf16(v[2], v[3]); w.z = cvt_pk_bf16(v[4], v[5]); w.w = cvt_pk_bf16(v[6], v[7]);
        *(u32x4*)(DFT + (size_t)j * S + c0) = w;
    }
}

__device__ __forceinline__ void phase_fold(const Params& p, int S, int lgS, int B, LAS unsigned char* lds) {
    unsigned char* const ws_ = ows(p);
    const int tid = otid(); bf16_t* FT = (bf16_t*)(ws_ + WS_BIG + BG_FT); const int hS = S >> 1;
    LAS bf16_t* rowl = (LAS bf16_t*)lds;
    for (int row = obid(); row < B * 256; row += gridDim.x) {
        bf16_t* rp = FT + (size_t)row * 2 * S;
        for (int c = tid; c < (S >> 2); c += 512) *(LAS u32x4*)(rowl + c * 8) = *(const u32x4*)(rp + c * 8);
        __syncthreads();
        for (int k = tid; k < S; k += 512) {
            float v;
            if (k <= hS) { v = bf2f(rowl[k]); if (k != 0 && k != hS) v += bf2f(rowl[S - k]); }
            else { const int kk = k - hS; v = bf2f(rowl[S + kk]) - bf2f(rowl[2 * S - kk]); }
            rp[k] = f2bf(v);
        }
        __syncthreads();
    }
}

__device__ __forceinline__ void phase_pq(const Params& p, int l) {
    unsigned char* const ws_ = ows(p);
    float* PQ = (float*)(ws_ + WS_PQ) + (size_t)l * 32768; const float* fw = p.in[9] + (size_t)l * 16384;
    for (int o = obid() * 512 + otid(); o < 32768; o += gridDim.x * 512) {
        const int part = o >> 14, g = (o >> 12) & 3, c = (o >> 6) & 63, d = o & 63; float acc = 0.f;
        for (int e = 0; e < 64; ++e) { const float fr = (float)((c * e) & 63) * (1.0f / 64.0f); const float t = part ? __builtin_amdgcn_sinf(fr) : __builtin_amdgcn_cosf(fr);
            acc += t * fw[(g * 64 + e) * 64 + d]; }
        PQ[o] = acc;
    }
}

__device__ __forceinline__ void tr_item(const float* W, int K, int Nsrc, int srccol, int nvalid, bf16_t* WT, int destrow0, const float* gain, LAS float* scr, int kb, int lane) {
    const int k0 = 64 * kb;
#pragma unroll 8
    for (int i = 0; i < 32; ++i) { const int kk = 2 * i + (lane >> 5); const int c = lane & 31;
        float v = (c < nvalid) ? W[(size_t)(k0 + kk) * Nsrc + srccol + c] : 0.f; if (gain) v *= gain[k0 + kk]; scr[kk * 33 + c] = v; }
    LDS_WAIT();
    const int c = lane & 7;
#pragma unroll
    for (int j = 0; j < 4; ++j) { const int n = (lane >> 3) + 8 * j; const LAS float* s = scr + (8 * c) * 33 + n;
        u32x4 o; o.x = cvt_pk_bf16(s[0 * 33], s[1 * 33]); o.y = cvt_pk_bf16(s[2 * 33], s[3 * 33]); o.z = cvt_pk_bf16(s[4 * 33], s[5 * 33]); o.w = cvt_pk_bf16(s[6 * 33], s[7 * 33]);
        *(u32x4*)(WT + (size_t)(destrow0 + n) * K + k0 + 8 * c) = o; }
    LDS_WAIT();
}
__device__ __forceinline__ void phase_weights(const Params& p, int l, LAS unsigned char* lds) {
    unsigned char* const ws_ = ows(p);
    const int tid = otid(), lane = tid & 63, wid = tid >> 6;
    const int gw = obid() * 8 + wid, NGW = gridDim.x * 8;
    LAS float* scr = (LAS float*)(lds + wid * 16384);
    bf16_t* W = (bf16_t*)(ws_ + WS_W);
    const float* ffn1n = p.in[4] + l * 1024; const float* gu1 = p.in[5] + (size_t)l * 1024 * 5632; const float* d1 = p.in[6] + (size_t)l * 2816 * 1024;
    const float* mixn = p.in[7] + l * 1024; const float* win = p.in[8] + (size_t)l * 1024 * 2064; const float* wout = p.in[16] + (size_t)l * 1048576;
    const float* mnx = p.in[17] + l * 1024; const float* mnm = p.in[18] + l * 1024; const float* wq = p.in[19] + (size_t)l * 1048576;
    const float* wkv = p.in[20] + (size_t)l * 2097152; const float* wo = p.in[21] + (size_t)l * 1048576;
    const float* ffn2n = p.in[22] + l * 1024; const float* gu2 = p.in[23] + (size_t)l * 1024 * 5632; const float* d2 = p.in[24] + (size_t)l * 2816 * 1024;
    for (int it = gw; it < 11520; it += NGW) {
        int r = it;
        if (r < 2816 || (r >= 7296 && r < 10112)) {
            const bool second = r >= 7296; if (second) r -= 7296;
            const int kb = r / 176, nb = r % 176, tile = nb >> 3, within = nb & 7, half = within >> 2, j32 = within & 3;
            tr_item(second ? gu2 : gu1, 1024, 5632, half * 2816 + tile * 128 + j32 * 32, 32, W + (second ? W_GU2 : W_GU1), nb * 32, second ? ffn2n : ffn1n, scr, kb, lane);
        } else if ((r >= 2816 && r < 4224) || r >= 10112) {
            const bool second = r >= 10112; r -= second ? 10112 : 2816;
            const int kb = r / 32, nb = r % 32;
            tr_item(second ? d2 : d1, 2816, 1024, nb * 32, 32, W + (second ? W_D2 : W_D1), nb * 32, nullptr, scr, kb, lane);
        } else if (r < 5248) {
            r -= 4224; const int kb = r / 64, nb = r % 64, d0 = nb * 32; int src, nv = 32;
            if (d0 < 512) src = 1296 + d0; else if (d0 < 640) src = 1808 + (d0 - 512); else if (d0 < 768) src = 1936 + (d0 - 640);
            else if (d0 < 1536) src = 256 + (d0 - 768); else if (d0 < 1792) src = 1040 + (d0 - 1536); else if (d0 == 1792) { src = 1024; nv = 16; } else { src = 0; nv = 0; }
            tr_item(win, 1024, 2064, src, nv, W + W_IN, d0, mixn, scr, kb, lane);
        } else if (r < 5760) { r -= 5248; tr_item(wout, 1024, 1024, (r % 32) * 32, 32, W + W_OUT, (r % 32) * 32, nullptr, scr, r / 32, lane);
        } else if (r < 6784) { r -= 5760; tr_item(wkv, 1024, 2048, (r % 64) * 32, 32, W + W_KV, (r % 64) * 32, mnm, scr, r / 64, lane);
        } else { r -= 6784; tr_item(wo, 1024, 1024, (r % 32) * 32, 32, W + W_OT, (r % 32) * 32, nullptr, scr, r / 32, lane); }
    }
    const float* PQ = (const float*)(ws_ + WS_PQ) + (size_t)l * 32768;
    for (int it = gw; it < 8192; it += NGW) {
        const int k = it >> 3, part = (it >> 2) & 1, g = it & 3; const float* wr = win + (size_t)k * 2064 + g * 64; const float* pq = PQ + ((part * 4 + g) * 64) * 64 + lane; float acc = 0.f;
#pragma unroll 8
        for (int c = 0; c < 64; ++c) acc += wr[c] * pq[c * 64];
        W[W_IN + (size_t)(2048 + part * 256 + g * 64 + lane) * 1024 + k] = f2bf(acc * mixn[k]);
    }
    for (int i = obid() * 512 + tid; i < 131072; i += gridDim.x * 512) {
        const int k = i >> 7, n0 = (i & 127) * 8; const float gsc = mnx[k] * QSCALE_MEM; const f32x4 a = *(const f32x4*)(wq + (size_t)k * 1024 + n0), b = *(const f32x4*)(wq + (size_t)k * 1024 + n0 + 4);
        u32x4 w; w.x = cvt_pk_bf16(a[0] * gsc, a[1] * gsc); w.y = cvt_pk_bf16(a[2] * gsc, a[3] * gsc); w.z = cvt_pk_bf16(b[0] * gsc, b[1] * gsc); w.w = cvt_pk_bf16(b[2] * gsc, b[3] * gsc);
        *(u32x4*)(W + W_QB + (size_t)k * 1024 + n0) = w;
    }
}

__device__ __forceinline__ void phase_qkrope(const Params& p, int l, int S, int lgS) {
    unsigned char* const ws_ = ows(p);
    bf16_t* Z = (bf16_t*)(ws_ + WS_BIG + BG_Z); const float* qn = p.in[14] + l * 64; const float* kn = p.in[15] + l * 64;
    const int total = NTOK * 40; const int tid = otid(), lane = tid & 63;
    for (int i = obid() * 512 + tid; i < total; i += gridDim.x * 512) {
        const int row = i / 40, rem = i - row * 40, head = rem >> 2, sub = rem & 3, axis = sub >> 1, fg = sub & 1;
        const bool isq = head < 8; const int colb = isq ? head * 64 : 512 + (head - 8) * 64; const float* nw = isq ? qn : kn;
        bf16_t* p1 = Z + (size_t)row * 2048 + colb + axis * 32 + fg * 8; bf16_t* p2 = p1 + 16;
        const u32x4 w1 = *(const u32x4*)p1, w2 = *(const u32x4*)p2;
        float x1[8], x2[8];
#pragma unroll
        for (int e = 0; e < 4; ++e) { x1[2 * e] = bflo(w1[e]); x1[2 * e + 1] = bfhi(w1[e]); x2[2 * e] = bflo(w2[e]); x2[2 * e + 1] = bfhi(w2[e]); }
        float ss = 0.f;
#pragma unroll
        for (int e = 0; e < 8; ++e) ss += x1[e] * x1[e] + x2[e] * x2[e];
        ss += shx(ss, 1, lane); ss += shx(ss, 2, lane);
        const float rs = rsqrtf(ss * (1.0f / 64.0f) + 1e-6f) * (isq ? QSCALE_GQA : 1.0f);
        const int n = row & (S - 1); const float pos = (float)(axis == 0 ? (n >> 6) : (n & 63));
        float o1[8], o2[8];
#pragma unroll
        for (int e = 0; e < 8; ++e) {
            const int f = fg * 8 + e; const float inv = __builtin_amdgcn_exp2f(-(float)f * 0.8304820237218406f);
            const float rev = pos * inv * 0.15915494309189535f; const float c = __builtin_amdgcn_cosf(rev), s = __builtin_amdgcn_sinf(rev);
            const float a = x1[e] * rs * nw[axis * 32 + f], b = x2[e] * rs * nw[axis * 32 + 16 + f];
            o1[e] = a * c - b * s; o2[e] = b * c + a * s;
        }
        u32x4 r1, r2;
#pragma unroll
        for (int e = 0; e < 4; ++e) { r1[e] = cvt_pk_bf16(o1[2 * e], o1[2 * e + 1]); r2[e] = cvt_pk_bf16(o2[2 * e], o2[2 * e + 1]); }
        *(u32x4*)p1 = r1; *(u32x4*)p2 = r2;
    }
}

__device__ __forceinline__ void phase_dnprep(const Params& p, int l, int S, int lgS, int B, LAS unsigned char* lds) {
    unsigned char* const ws_ = ows(p);
    const int tid = otid(), lane = tid & 63, wid = __builtin_amdgcn_readfirstlane(tid >> 6), r32 = lane & 31, hi = lane >> 5;
    LAS float* qf = (LAS float*)lds; LAS float* kf = qf + 64 * 65; LAS float* vf = kf + 64 * 65; LAS float* G = vf + 64 * 65; LAS float* QK = G + 64 * 65;
    LAS float* Lm = QK + 64 * 65; LAS bf16_t* qh = (LAS bf16_t*)(Lm + 2 * 4096); LAS bf16_t* kh = qh + 64 * 72;
    LAS float* gs = (LAS float*)(kh + 64 * 72); LAS float* bs = gs + 128; LAS float* gc = bs + 128;
    const bf16_t* Z = (const bf16_t*)(ws_ + WS_BIG + BG_Z); const float* AB = (const float*)(ws_ + WS_AB);
    bf16_t* DN = (bf16_t*)(ws_ + WS_DN); float* GL = (float*)(ws_ + WS_GL);
    const float* conv = p.in[10] + (size_t)l * 3 * 768; const float* Alog = p.in[11] + l * 8; const float* dtb = p.in[12] + l * 8;
    const int Nc = S >> 6; const int nunits = NTOK / 64 * 4;
    for (int unit = obid(); unit < nunits; unit += gridDim.x) {
        const int h = unit & 3, gch = unit >> 2, b = gch >> (lgS - 6), n = gch & (Nc - 1), tok0 = gch * 64;
        {
            const int t = tid >> 3, s8 = tid & 7, row = tok0 + t, npos = n * 64 + t;
            const bf16_t* zr = Z + (size_t)row * 2048 + 768 + h * 64 + s8 * 8;
            float aq[8], ak[8], av[8];
#pragma unroll
            for (int e = 0; e < 8; ++e) { aq[e] = 0.f; ak[e] = 0.f; av[e] = 0.f; }
#pragma unroll
            for (int tap = 0; tap < 3; ++tap) {
                const int pp = npos + tap - 1;
                if (pp >= 0 && pp < S) {
                    const bf16_t* zz = zr + (tap - 1) * 2048; const u32x4 wq_ = *(const u32x4*)zz, wk_ = *(const u32x4*)(zz + 256), wv_ = *(const u32x4*)(zz + 512);
                    const float* cw = conv + tap * 768 + h * 64 + s8 * 8;
                    const f32x4 cq0 = *(const f32x4*)cw, cq1 = *(const f32x4*)(cw + 4), ck0 = *(const f32x4*)(cw + 256), ck1 = *(const f32x4*)(cw + 260), cv0 = *(const f32x4*)(cw + 512), cv1 = *(const f32x4*)(cw + 516);
#pragma unroll
                    for (int e = 0; e < 4; ++e) {
                        const float wq0 = e < 2 ? cq0[2 * e] : cq1[2 * e - 4], wq1 = e < 2 ? cq0[2 * e + 1] : cq1[2 * e - 3];
                        const float wk0 = e < 2 ? ck0[2 * e] : ck1[2 * e - 4], wk1 = e < 2 ? ck0[2 * e + 1] : ck1[2 * e - 3];
                        const float wv0 = e < 2 ? cv0[2 * e] : cv1[2 * e - 4], wv1 = e < 2 ? cv0[2 * e + 1] : cv1[2 * e - 3];
                        aq[2 * e] += bflo(wq_[e]) * wq0; aq[2 * e + 1] += bfhi(wq_[e]) * wq1;
                        ak[2 * e] += bflo(wk_[e]) * wk0; ak[2 * e + 1] += bfhi(wk_[e]) * wk1;
                        av[2 * e] += bflo(wv_[e]) * wv0; av[2 * e + 1] += bfhi(wv_[e]) * wv1;
                    }
                }
            }
            float sq = 0.f, sk = 0.f;
#pragma unroll
            for (int e = 0; e < 8; ++e) { aq[e] = aq[e] * __builtin_amdgcn_rcpf(1.0f + __expf(-aq[e])); ak[e] = ak[e] * __builtin_amdgcn_rcpf(1.0f + __expf(-ak[e])); av[e] = av[e] * __builtin_amdgcn_rcpf(1.0f + __expf(-av[e]));
                sq += aq[e] * aq[e]; sk += ak[e] * ak[e]; }
            sq += shx(sq, 1, lane); sq += shx(sq, 2, lane); sq += shx(sq, 4, lane);
            sk += shx(sk, 1, lane); sk += shx(sk, 2, lane); sk += shx(sk, 4, lane);
            const float rq = rsqrtf(sq + 1e-6f) * 0.125f, rk = rsqrtf(sk + 1e-6f);
#pragma unroll
            for (int e = 0; e < 8; ++e) { aq[e] *= rq; ak[e] *= rk; qf[t * 65 + s8 * 8 + e] = aq[e]; kf[t * 65 + s8 * 8 + e] = ak[e]; vf[t * 65 + s8 * 8 + e] = av[e]; }
            *(LAS bf16x8*)(qh + t * 72 + s8 * 8) = pack8(aq[0], aq[1], aq[2], aq[3], aq[4], aq[5], aq[6], aq[7]);
            *(LAS bf16x8*)(kh + t * 72 + s8 * 8) = pack8(ak[0], ak[1], ak[2], ak[3], ak[4], ak[5], ak[6], ak[7]);
            if (s8 < 2) {
                const int dir = s8; const float a = AB[(size_t)row * 16 + dir * 4 + h], bb = AB[(size_t)row * 16 + 8 + dir * 4 + h];
                const float xx = a + dtb[dir * 4 + h]; const float sp = xx > 20.f ? xx : log1pf(expf(xx));
                gs[dir * 64 + t] = -expf(Alog[dir * 4 + h]) * sp; bs[dir * 64 + t] = 1.0f / (1.0f + expf(-bb));
            }
        }
        __syncthreads();
        {
            const int mat = wid >> 2, ti = (wid >> 1) & 1, tj = wid & 1; const LAS bf16_t* am = mat ? qh : kh;
            f32x16 acc = {0.f, 0.f, 0.f, 0.f, 0.f, 0.f, 0.f, 0.f, 0.f, 0.f, 0.f, 0.f, 0.f, 0.f, 0.f, 0.f};
#pragma unroll
            for (int d0 = 0; d0 < 4; ++d0) { const bf16x8 a = *(const LAS bf16x8*)(am + (32 * ti + r32) * 72 + 16 * d0 + 8 * hi), bq = *(const LAS bf16x8*)(kh + (32 * tj + r32) * 72 + 16 * d0 + 8 * hi);
                acc = __builtin_amdgcn_mfma_f32_32x32x16_bf16(a, bq, acc, 0, 0, 0); }
            LAS float* M = mat ? QK : G;
#pragma unroll
            for (int r = 0; r < 16; ++r) M[(32 * ti + crow(r, hi)) * 65 + 32 * tj + r32] = acc[r];
            if (wid < 2) { const int dir = wid; float v = gs[dir * 64 + (dir ? 63 - lane : lane)];
#pragma unroll
                for (int o = 1; o < 64; o <<= 1) { const float tt = __int_as_float(__builtin_amdgcn_ds_bpermute(((lane - o) & 63) << 2, __float_as_int(v))); if (lane >= o) v += tt; }
                gc[dir * 64 + lane] = v; }
        }
        __syncthreads();
        const int m0 = n, m1 = Nc - 1 - n;
        bf16_t* dn0 = DN + ((((size_t)(b * 4 + h) * 2 + 0) * Nc + m0) * 20480); bf16_t* dn1 = DN + ((((size_t)(b * 4 + h) * 2 + 1) * Nc + m1) * 20480);
        {
            const int dir = tid >> 8, i = (tid >> 2) & 63, jq = tid & 3, ti_ = dir ? 63 - i : i; const float gci = gc[dir * 64 + i], bi = bs[dir * 64 + ti_];
            float qv[16];
#pragma unroll
            for (int e = 0; e < 16; ++e) { const int j = jq * 16 + e, tj_ = dir ? 63 - j : j; const float dec = (j <= i) ? __expf(gci - gc[dir * 64 + j]) : 0.f;
                Lm[dir * 4096 + i * 64 + j] = (j < i) ? bi * G[ti_ * 65 + tj_] * dec : 0.f; qv[pos16(e)] = QK[ti_ * 65 + tj_] * dec; }
            bf16_t* dst = (dir ? dn1 : dn0) + 2 * 4096 + i * 64 + jq * 16;
            *(bf16x8*)dst = pack8(qv[0], qv[1], qv[2], qv[3], qv[4], qv[5], qv[6], qv[7]); *(bf16x8*)(dst + 8) = pack8(qv[8], qv[9], qv[10], qv[11], qv[12], qv[13], qv[14], qv[15]);
        }
        __syncthreads();
        if (wid < 4) {
            const int dir = wid >> 1, half = wid & 1; const LAS float* src = half ? kf : vf; const LAS float* L = Lm + dir * 4096;
            float x[64]; const int rb_ = dir ? 63 : 0, rs_ = dir ? -1 : 1;
#pragma unroll
            for (int i = 0; i < 64; ++i) { const int ti_ = rb_ + rs_ * i; const float r = src[ti_ * 65 + lane] * bs[dir * 64 + ti_]; const float e = __expf(gc[dir * 64 + i]); x[i] = half ? r * e : r; }
#pragma unroll
            for (int i = 1; i < 64; ++i) { float s0 = x[i], s1 = 0.f, s2 = 0.f, s3 = 0.f; const LAS f32x4* Lr = (const LAS f32x4*)(L + i * 64);
#pragma unroll
                for (int j4 = 0; j4 < (i + 3) / 4; ++j4) { const f32x4 lv = Lr[j4]; s0 -= lv[0] * x[4 * j4]; s1 -= lv[1] * x[4 * j4 + 1]; s2 -= lv[2] * x[4 * j4 + 2]; s3 -= lv[3] * x[4 * j4 + 3]; }
                x[i] = (s0 + s1) + (s2 + s3); }
            bf16_t* dn = dir ? dn1 : dn0;
            if (half == 0) {
                const int ch = lane >> 5, nn = lane & 31;
#pragma unroll
                for (int T = 0; T < 2; ++T)
#pragma unroll
                    for (int hh = 0; hh < 2; ++hh) { bf16_t* d = dn + 4 * 4096 + ((ch * 2 + T) * 64 + hh * 32 + nn) * 16;
#define XR(r) x[32 * T + ((r) & 3) + 8 * ((r) >> 2) + 4 * hh]
                        *(bf16x8*)d = pack8(XR(0), XR(1), XR(2), XR(3), XR(4), XR(5), XR(6), XR(7)); *(bf16x8*)(d + 8) = pack8(XR(8), XR(9), XR(10), XR(11), XR(12), XR(13), XR(14), XR(15));
#undef XR
                    }
            } else {
                const int pc = (lane & ~15) + pos16(lane & 15);
#pragma unroll
                for (int i = 0; i < 64; ++i) dn[i * 64 + pc] = f2bf(-x[i]);
            }
        } else {
            const int dir = (wid >> 1) & 1, which = wid & 1; bf16_t* dn = dir ? dn1 : dn0;
            if (which == 0) { const int pc = (lane & ~15) + pos16(lane & 15);
#pragma unroll 8
                for (int i = 0; i < 64; ++i) { const int ti_ = dir ? 63 - i : i; dn[4096 + i * 64 + pc] = f2bf(qf[ti_ * 65 + lane] * __expf(gc[dir * 64 + i])); }
            } else { const int i = (lane & ~15) + pos16(lane & 15); const int ti_ = dir ? 63 - i : i; const float glast = gc[dir * 64 + 63]; const float sc = __expf(glast - gc[dir * 64 + i]);
#pragma unroll 8
                for (int d = 0; d < 64; ++d) dn[3 * 4096 + d * 64 + lane] = f2bf(kf[ti_ * 65 + d] * sc);
                if (lane == 0) GL[((size_t)(b * 4 + h) * 2 + dir) * Nc + (dir ? m1 : m0)] = __expf(glast); }
        }
        __syncthreads();
    }
}

__device__ __forceinline__ void phase_dnscan(const Params& p, int S, int lgS, int B) {
    unsigned char* const ws_ = ows(p);
    const int tid = otid(), lane = tid & 63, wid = __builtin_amdgcn_readfirstlane(tid >> 6), r32 = lane & 31, hi = lane >> 5;
    const int wk = wid * gridDim.x + obid(); if (wk >= B * 16) return;
    const int half = wk & 1, dir = (wk >> 1) & 1, h = (wk >> 2) & 3, b = wk >> 4; const int Nc = S >> 6;
    const bf16_t* DN = (const bf16_t*)(ws_ + WS_DN) + ((size_t)(b * 4 + h) * 2 + dir) * Nc * 20480; const float* GL = (const float*)(ws_ + WS_GL) + ((size_t)(b * 4 + h) * 2 + dir) * Nc;
    float* O2 = (float*)(ws_ + WS_X1) + (size_t)dir * NTOK * 256;
    f32x16 s0 = {0.f, 0.f, 0.f, 0.f, 0.f, 0.f, 0.f, 0.f, 0.f, 0.f, 0.f, 0.f, 0.f, 0.f, 0.f, 0.f}, s1 = s0;
    const f32x16 zero16 = s0;
    for (int m = 0; m < Nc; ++m) {
        const bf16_t* base = DN + (size_t)m * 20480; const float eg = GL[m];
        bf16x8 aw[2][4], aqd[2][4], aqk[2][4], akt[2][4]; u32x4 uu[2][2];
#pragma unroll
        for (int T = 0; T < 2; ++T) {
            const u32x4* up = (const u32x4*)(base + 4 * 4096 + ((half * 2 + T) * 64 + lane) * 16); uu[T][0] = up[0]; uu[T][1] = up[1];
#pragma unroll
            for (int kk = 0; kk < 4; ++kk) aw[T][kk] = *(const bf16x8*)(base + (32 * T + r32) * 64 + 16 * kk + 8 * hi);
        }
#pragma unroll
        for (int T = 0; T < 2; ++T)
#pragma unroll
            for (int kk = 0; kk < 4; ++kk) { aqd[T][kk] = *(const bf16x8*)(base + 4096 + (32 * T + r32) * 64 + 16 * kk + 8 * hi); aqk[T][kk] = *(const bf16x8*)(base + 2 * 4096 + (32 * T + r32) * 64 + 16 * kk + 8 * hi);
                akt[T][kk] = *(const bf16x8*)(base + 3 * 4096 + (32 * T + r32) * 64 + 16 * kk + 8 * hi); }
        asm volatile("" ::: "memory");
        bf16x8 sb[4];
        sb[0] = pack8(s0[0], s0[1], s0[2], s0[3], s0[4], s0[5], s0[6], s0[7]); sb[1] = pack8(s0[8], s0[9], s0[10], s0[11], s0[12], s0[13], s0[14], s0[15]);
        sb[2] = pack8(s1[0], s1[1], s1[2], s1[3], s1[4], s1[5], s1[6], s1[7]); sb[3] = pack8(s1[8], s1[9], s1[10], s1[11], s1[12], s1[13], s1[14], s1[15]);
        f32x16 vn[2];
#pragma unroll
        for (int T = 0; T < 2; ++T) {
            f32x16 c;
#pragma unroll
            for (int e = 0; e < 4; ++e) { c[2 * e] = bflo(uu[T][0][e]); c[2 * e + 1] = bfhi(uu[T][0][e]); c[8 + 2 * e] = bflo(uu[T][1][e]); c[9 + 2 * e] = bfhi(uu[T][1][e]); }
#pragma unroll
            for (int kk = 0; kk < 4; ++kk) c = __builtin_amdgcn_mfma_f32_32x32x16_bf16(aw[T][kk], sb[kk], c, 0, 0, 0);
            vn[T] = c;
        }
        bf16x8 vb[4];
        vb[0] = pack8(vn[0][0], vn[0][1], vn[0][2], vn[0][3], vn[0][4], vn[0][5], vn[0][6], vn[0][7]); vb[1] = pack8(vn[0][8], vn[0][9], vn[0][10], vn[0][11], vn[0][12], vn[0][13], vn[0][14], vn[0][15]);
        vb[2] = pack8(vn[1][0], vn[1][1], vn[1][2], vn[1][3], vn[1][4], vn[1][5], vn[1][6], vn[1][7]); vb[3] = pack8(vn[1][8], vn[1][9], vn[1][10], vn[1][11], vn[1][12], vn[1][13], vn[1][14], vn[1][15]);
        const int nchunk = dir ? Nc - 1 - m : m;
        int hi_ = hi; asm volatile("" : "+v"(hi_));
        float* orow = O2 + ((size_t)(b * S + nchunk * 64) * 256 + h * 64 + half * 32 + r32); const int rstep = dir ? -256 : 256; if (dir) orow += 63 * 256;
#pragma unroll
        for (int T = 0; T < 2; ++T) {
            f32x16 o = zero16;
#pragma unroll
            for (int kk = 0; kk < 4; ++kk) o = __builtin_amdgcn_mfma_f32_32x32x16_bf16(aqd[T][kk], sb[kk], o, 0, 0, 0);
#pragma unroll
            for (int kk = 0; kk < 4; ++kk) o = __builtin_amdgcn_mfma_f32_32x32x16_bf16(aqk[T][kk], vb[kk], o, 0, 0, 0);
#pragma unroll
            for (int r = 0; r < 16; ++r) { const int i = 32 * T + crow(r, hi_); orow[i * rstep] = o[r]; }
        }
        s0 = s0 * eg; s1 = s1 * eg;
#pragma unroll
        for (int kk = 0; kk < 4; ++kk) { s0 = __builtin_amdgcn_mfma_f32_32x32x16_bf16(akt[0][kk], vb[kk], s0, 0, 0, 0); s1 = __builtin_amdgcn_mfma_f32_32x32x16_bf16(akt[1][kk], vb[kk], s1, 0, 0, 0); }
    }
}

__device__ __forceinline__ void phase_dncombine(const Params& p, int l) {
    unsigned char* const ws_ = ows(p);
    const float* O2 = (const float*)(ws_ + WS_X1); const bf16_t* Z = (const bf16_t*)(ws_ + WS_BIG + BG_Z); bf16_t* YC = (bf16_t*)(ws_ + WS_YC); const float* on = p.in[13] + l * 64;
    const int total = NTOK * 32; const int tid = otid(), lane = tid & 63;
    for (int i = obid() * 512 + tid; i < total; i += gridDim.x * 512) {
        const int row = i >> 5, c0 = (i & 31) * 8;
        const f32x4 a0 = *(const f32x4*)(O2 + (size_t)row * 256 + c0), a1 = *(const f32x4*)(O2 + (size_t)row * 256 + c0 + 4);
        const f32x4 b0 = *(const f32x4*)(O2 + (size_t)(NTOK + row) * 256 + c0), b1 = *(const f32x4*)(O2 + (size_t)(NTOK + row) * 256 + c0 + 4);
        float o[8] = {a0[0] + b0[0], a0[1] + b0[1], a0[2] + b0[2], a0[3] + b0[3], a1[0] + b1[0], a1[1] + b1[1], a1[2] + b1[2], a1[3] + b1[3]};
        float ss = 0.f;
#pragma unroll
        for (int e = 0; e < 8; ++e) ss += o[e] * o[e];
        ss += shx(ss, 1, lane); ss += shx(ss, 2, lane); ss += shx(ss, 4, lane);
        const float rs = rsqrtf(ss * (1.0f / 64.0f) + 1e-6f);
        const u32x4 gw = *(const u32x4*)(Z + (size_t)row * 2048 + 1536 + c0);
        float r[8];
#pragma unroll
        for (int e = 0; e < 8; ++e) { const float g = (e & 1) ? bfhi(gw[e >> 1]) : bflo(gw[e >> 1]); r[e] = o[e] * rs * on[(c0 & 63) + e] * g * __builtin_amdgcn_rcpf(1.0f + __expf(-g)); }
        *(bf16x8*)(YC + (size_t)row * 1024 + 256 + c0) = pack8(r[0], r[1], r[2], r[3], r[4], r[5], r[6], r[7]);
    }
}

__device__ __forceinline__ void phase_attn(const Params& p, int S, int lgS, int B, int* counter, LAS unsigned char* lds) {
    unsigned char* const ws_ = ows(p);
    const int tid = otid(), lane = tid & 63, wid = __builtin_amdgcn_readfirstlane(tid >> 6), r32 = lane & 31, hi = lane >> 5;
    const bf16_t* Z = (const bf16_t*)(ws_ + WS_BIG + BG_Z); const bf16_t* VT = (const bf16_t*)(ws_ + WS_BIG + BG_VT); bf16_t* YC = (bf16_t*)(ws_ + WS_YC);
    constexpr int KB = 128 * 72 * 2, BUFB = KB + 64 * 136 * 2;
    const int nqt = S >> 8, lgq = lgS - 8, nunits = B * 8 * nqt, NT = S >> 7;
    LAS float* wsf = (LAS float*)(lds + 2 * BUFB + wid * 256);
    const int skey = tid >> 3, spc = tid & 7;
    const int kdst = (skey * 72 + spc * 8) * 2, vdst = KB + (skey * 136 + spc * 8) * 2;
    const int klane = (r32 * 72 + 8 * hi) * 2, vlane = (r32 * 136 + 4 * hi) * 2;
    const int G_ = (int)gridDim.x, bid_ = obid(), nscan = B * 16, per = nunits / G_;
    const bool deal = (nunits % G_ == 0) && (2 * nscan <= G_) && (per >= 2);
    const int nmine = !deal ? ((bid_ < nunits) ? (nunits - bid_ + G_ - 1) / G_ : 0) : (bid_ < nscan ? per - 1 : (bid_ < 2 * nscan ? per + 1 : per));
    for (int ui = 0; ui < nmine; ++ui) {
        const int unit = (deal && ui == per) ? (bid_ - nscan) + G_ * (per - 1) : bid_ + ui * G_;
        const int hq4 = unit & 3, qt = (unit >> 2) & (nqt - 1), bk = unit >> (2 + lgq), kvh = bk & 1, b = bk >> 1, qh = kvh * 4 + hq4;
        const size_t rowq = (size_t)b * S + qt * 256 + wid * 32 + r32;
        bf16x8 qr[4];
#pragma unroll
        for (int d0 = 0; d0 < 4; ++d0) qr[d0] = *(const bf16x8*)(Z + rowq * 2048 + qh * 64 + d0 * 16 + hi * 8);
        const bf16_t* ksrc = Z + ((size_t)b * S + skey) * 2048 + 512 + kvh * 64 + spc * 8;
        const bf16_t* vsrc = VT + (((size_t)(b * 128 + kvh * 64 + skey)) << lgS) + spc * 8;
        u32x4 kreg0 = *(const u32x4*)ksrc, kreg1 = *(const u32x4*)(ksrc + (size_t)64 * 2048), vreg0 = *(const u32x4*)vsrc, vreg1 = *(const u32x4*)(vsrc + 64);
        *(LAS u32x4*)(lds + kdst) = kreg0; *(LAS u32x4*)(lds + kdst + 64 * 144) = kreg1; *(LAS u32x4*)(lds + vdst) = vreg0; *(LAS u32x4*)(lds + vdst + 128) = vreg1;
        __syncthreads();
        float m_run = 0.f, l_run = 0.f;
        f32x16 o0 = {0.f, 0.f, 0.f, 0.f, 0.f, 0.f, 0.f, 0.f, 0.f, 0.f, 0.f, 0.f, 0.f, 0.f, 0.f, 0.f}, o1 = o0; const f32x16 zero16 = o0; f32x16 negm = o0;
        for (int t = 0; t < NT; ++t) {
            const LAS unsigned char* kb = lds + (t & 1) * BUFB; const LAS unsigned char* vb = kb + KB;
            if (t + 1 < NT) { const bf16_t* kn = ksrc + (size_t)(t + 1) * 128 * 2048; const bf16_t* vn_ = vsrc + (t + 1) * 128;
                kreg0 = *(const u32x4*)kn; kreg1 = *(const u32x4*)(kn + (size_t)64 * 2048); vreg0 = *(const u32x4*)vn_; vreg1 = *(const u32x4*)(vn_ + 64); }
            f32x16 pp[4] = {negm, negm, negm, negm};
            const LAS unsigned char* kl = kb + klane; const LAS unsigned char* vl = vb + vlane;
#pragma unroll
            for (int d0 = 0; d0 < 4; ++d0)
#pragma unroll
                for (int j = 0; j < 4; ++j) { const bf16x8 a = *(const LAS bf16x8*)(kl + (32 * j * 72 + 16 * d0) * 2); pp[j] = __builtin_amdgcn_mfma_f32_32x32x16_bf16(a, qr[d0], pp[j], 0, 0, 0); }
            float mxa = fmaxf(pp[0][0], pp[1][0]), mxb = fmaxf(pp[2][0], pp[3][0]);
#pragma unroll
            for (int r = 1; r < 16; ++r) { mxa = fmaxf(fmaxf(mxa, pp[0][r]), pp[1][r]); mxb = fmaxf(fmaxf(mxb, pp[2][r]), pp[3][r]); }
            float mx = fmaxf(mxa, mxb);
            mx = fmaxf(mx, shx(mx, 32, lane));
            const bool first = (t == 0);
            if (first || __any(mx > 8.f)) {
                const float d = first ? mx : fmaxf(mx, 0.f);
                m_run += d;
#pragma unroll
                for (int j = 0; j < 4; ++j)
#pragma unroll
                    for (int r = 0; r < 16; ++r) pp[j][r] -= d;
#pragma unroll
                for (int r = 0; r < 16; ++r) negm[r] = -m_run;
                if (!first) {
                    const float alpha = __builtin_amdgcn_exp2f(-d); l_run *= alpha;
                    if (hi == 0) wsf[r32] = alpha;
                    LDS_WAIT();
#pragma unroll
                    for (int r = 0; r < 16; ++r) { const float f = wsf[crow(r, hi)]; o0[r] *= f; o1[r] *= f; }
                    LDS_WAIT();
                }
            }
            float ls = 0.f;
#pragma unroll
            for (int j = 0; j < 4; ++j)
#pragma unroll
                for (int r = 0; r < 16; ++r) { pp[j][r] = __builtin_amdgcn_exp2f(pp[j][r]); ls += pp[j][r]; }
            l_run += ls;
#pragma unroll
            for (int j = 0; j < 4; ++j)
#pragma unroll
                for (int kk = 0; kk < 2; ++kk) {
                    const int ks = 2 * j + kk;
                    const bf16x8 pa = pack8(pp[j][8 * kk], pp[j][8 * kk + 1], pp[j][8 * kk + 2], pp[j][8 * kk + 3], pp[j][8 * kk + 4], pp[j][8 * kk + 5], pp[j][8 * kk + 6], pp[j][8 * kk + 7]);
                    const u32x2 v0a = *(const LAS u32x2*)(vl + (16 * ks) * 2), v0b = *(const LAS u32x2*)(vl + (16 * ks + 8) * 2);
                    const u32x2 v1a = *(const LAS u32x2*)(vl + (32 * 136 + 16 * ks) * 2), v1b = *(const LAS u32x2*)(vl + (32 * 136 + 16 * ks + 8) * 2);
                    const u32x4 f0 = {v0a.x, v0a.y, v0b.x, v0b.y}, f1 = {v1a.x, v1a.y, v1b.x, v1b.y};
                    o0 = __builtin_amdgcn_mfma_f32_32x32x16_bf16(pa, __builtin_bit_cast(bf16x8, f0), o0, 0, 0, 0);
                    o1 = __builtin_amdgcn_mfma_f32_32x32x16_bf16(pa, __builtin_bit_cast(bf16x8, f1), o1, 0, 0, 0);
                }
            if (t + 1 < NT) { LAS unsigned char* nb = lds + ((t + 1) & 1) * BUFB;
                *(LAS u32x4*)(nb + kdst) = kreg0; *(LAS u32x4*)(nb + kdst + 64 * 144) = kreg1; *(LAS u32x4*)(nb + vdst) = vreg0; *(LAS u32x4*)(nb + vdst + 128) = vreg1; }
            __syncthreads();
        }
        l_run += shx(l_run, 32, lane);
        if (hi == 0) wsf[32 + r32] = l_run;
        LDS_WAIT();
        bf16_t* orow = YC + ((size_t)b * S + qt * 256 + wid * 32) * 1024 + 512 + qh * 64;
#pragma unroll
        for (int r = 0; r < 16; ++r) { const int q = crow(r, hi); const float inv = 1.0f / wsf[32 + q];
            orow[(size_t)q * 1024 + r32] = f2bf(o0[r] * inv); orow[(size_t)q * 1024 + 32 + r32] = f2bf(o1[r] * inv); }
        LDS_WAIT();
    }
}

__device__ __forceinline__ void phase_final(const Params& p, float* X) {
    unsigned char* const ws_ = ows(p);
    const int tid = otid(), lane = tid & 63, wid = tid >> 6; const int gw = obid() * 8 + wid, NGW = gridDim.x * 8;
    const float* ssq = (const float*)(ws_ + WS_SSQ); const f32x4* fw = (const f32x4*)p.in[25] + lane;
    f32x4 w[4];
#pragma unroll
    for (int j = 0; j < 4; ++j) w[j] = fw[64 * j];
    for (int row = gw; row < NTOK; row += NGW) {
        const float rs = row_rstd(ssq, row); f32x4* xr = (f32x4*)(X + (size_t)row * 1024) + lane;
#pragma unroll
        for (int j = 0; j < 4; ++j) { const f32x4 v = xr[64 * j]; xr[64 * j] = v * rs * w[j]; }
    }
}

#define XB_TMO      128
#define XB_XCNT(j)  (256  + 64 * (j))
#define XB_XSUB(j)  (1280 + 64 * (j))
#define XB_XGEN(j)  (2304 + 64 * (j))
#define XB_TOP      3328
#define XB_TOPGEN   3392
#define XCD_BAR_WORDS 3456
#define XB_SPIN_CAP (1u << 22)
__device__ __forceinline__ unsigned xb_ld(unsigned* p)              { return __hip_atomic_load(p, __ATOMIC_RELAXED, __HIP_MEMORY_SCOPE_AGENT); }
__device__ __forceinline__ unsigned xb_add(unsigned* p, unsigned v) { return __hip_atomic_fetch_add(p, v, __ATOMIC_RELAXED, __HIP_MEMORY_SCOPE_AGENT); }
__device__ __forceinline__ unsigned xb_xcc_id() { return (unsigned)__builtin_amdgcn_s_getreg((3 << 11) | 20) & 0xFu; }
#define XB_SPIN(cond, bar) do { unsigned _sp = 0; while (cond) { __builtin_amdgcn_s_sleep(1); \
    if ((++_sp & 255u) == 0u) { if (xb_ld(&(bar)[XB_TMO])) break; if (_sp > XB_SPIN_CAP) { atomicAdd(&(bar)[XB_TMO], 1u); break; } } } } while (0)
__device__ __forceinline__ void xcd_barrier_complete(unsigned* bar, unsigned x, unsigned& nloc, unsigned& nx) {
    const unsigned G = gridDim.x * gridDim.y * gridDim.z;
    unsigned sum, cnt, mine, sp = 0u;
    for (;;) {
        sum = 0u; cnt = 0u; mine = 0u;
#pragma unroll
        for (unsigned j = 0; j < 16; ++j) { const unsigned c = xb_ld(&bar[XB_XCNT(j)]); sum += c; cnt += (c > 0u) ? 1u : 0u; mine = (j == x) ? c : mine; }
        if (sum == G) break;
        __builtin_amdgcn_s_sleep(1);
        if ((++sp & 255u) == 0u) { if (xb_ld(&bar[XB_TMO])) break; if (sp > XB_SPIN_CAP) { atomicAdd(&bar[XB_TMO], 1u); break; } }
    }
    nloc = mine > 0u ? mine : 1u; nx = cnt > 0u ? cnt : 1u;
}
__device__ __forceinline__ void xcd_barrier(unsigned* bar, volatile LAS unsigned* st) {
    asm volatile("s_waitcnt vmcnt(0) lgkmcnt(0)" ::: "memory");
    __syncthreads();
    if (threadIdx.x == 0) {
        __builtin_amdgcn_s_waitcnt(0);
        const unsigned x = xb_xcc_id();
        unsigned nloc = st[0], nx = st[1];
        if (nloc == 0u) { xcd_barrier_complete(bar, x, nloc, nx); st[0] = nloc; st[1] = nx; }
        const unsigned old = xb_add(&bar[XB_XSUB(x)], 1u);
        const unsigned gen = old / nloc;
        if (old + 1u == (gen + 1u) * nloc) {
            __builtin_amdgcn_fence(__ATOMIC_RELEASE, "agent");
            asm volatile("s_waitcnt vmcnt(0)" ::: "memory");
            const unsigned og = xb_add(&bar[XB_TOP], 1u);
            const unsigned tg = og / nx;
            if (og + 1u == (tg + 1u) * nx) xb_add(&bar[XB_TOPGEN], 1u);
            else XB_SPIN(xb_ld(&bar[XB_TOPGEN]) == tg, bar);
            __builtin_amdgcn_fence(__ATOMIC_ACQUIRE, "agent");
            xb_add(&bar[XB_XGEN(x)], 1u);
            asm volatile("s_waitcnt vmcnt(0)" ::: "memory");
        } else {
            XB_SPIN(xb_ld(&bar[XB_XGEN(x)]) == gen, bar);
            __builtin_amdgcn_fence(__ATOMIC_ACQUIRE, "agent");
            asm volatile("s_waitcnt vmcnt(0)" ::: "memory");
        }
    }
    __syncthreads();
}
#define GRID_SYNC() xcd_barrier((unsigned*)(p.ws + WS_CNT + 4096), (volatile LAS unsigned*)(lds + XB_LDS_OFF))
__global__ void __launch_bounds__(512, 2) mega_fwd(Params p) {
    extern __shared__ __attribute__((aligned(16))) unsigned char lds_raw[];
    LAS unsigned char* lds = (LAS unsigned char*)lds_raw;
    cg::grid_group grid = cg::this_grid();
    if (threadIdx.x < 4) ((LAS unsigned*)(lds + XB_LDS_OFF))[threadIdx.x] = 0u;
    __syncthreads();
    if (threadIdx.x == 0) (void)xb_add((unsigned*)(p.ws + WS_CNT + 4096) + XB_XCNT(xb_xcc_id()), 1u);
    grid.sync();
#ifdef PROBE_ZERO
    {
        u32x4* z = (u32x4*)p.ws; const size_t n = WS_END / 16; const u32x4 zz = {0u, 0u, 0u, 0u};
        for (size_t i = (size_t)blockIdx.x * 512 + threadIdx.x; i < n; i += (size_t)gridDim.x * 512) { if (i < WS_CNT / 16 || i >= (WS_CNT + 4096) / 16) z[i] = zz; }
        GRID_SYNC();
    }
#endif
    const int G = gridDim.x;
#define KW_PTRS unsigned char* const ws = ows(p); const int cid = obid(); bf16_t* const W = (bf16_t*)(ws + WS_W); bf16_t* const X1 = (bf16_t*)(ws + WS_X1); bf16_t* const YC = (bf16_t*)(ws + WS_YC); unsigned char* const BIG = ws + WS_BIG; \
    float* const ssq = (float*)(ws + WS_SSQ); const float* const mssq = (const float*)(ws + WS_MSSQ); (void)W; (void)X1; (void)YC; (void)BIG; (void)ssq; (void)mssq; (void)cid;
    for (int pass = 0; pass < 2; ++pass) {
        const int grp = 1 - pass; const int S = grp ? 8192 : 2048, lgS = grp ? 13 : 11, B = grp ? 8 : 32;
        float* X = p.out + (grp ? (size_t)67108864 : (size_t)0);
        bf16_t* DFT = grp ? (bf16_t*)p.out : (bf16_t*)(p.ws + WS_DFT2);
        if (PH(0)) phase_init(p, grp, S, lgS, B, X, DFT);
        for (int l = 0; l < 2; ++l) {
            if (l == 0) { if (PH(1)) { phase_pq(p, 0); phase_pq(p, 1); } GRID_SYNC(); }
            if (PH(2)) phase_weights(p, l, lds);
            GRID_SYNC();
            for (int rep = 0; rep < REP_SYNC; ++rep) { GRID_SYNC(); }
            for (int f = 0; f < 2; ++f) {
                if (f == 1) {
                    if (EN_MIX && PH(3)) { KW_PTRS pg8::Gemm g{X1, W + W_IN, 1024, 1024, 1024}; pg8::StaticOrder so; so.init(256, 10, G, cid);
                      pg8::EpiWin E{(bf16_t*)(BIG + BG_Z), (bf16_t*)(BIG + BG_FT), (bf16_t*)(BIG + BG_VT), (float*)(ws + WS_AB), ssq, S, lgS};
                      pg8::gemm_phase(lds, g, so, pg8::AddrStd{}, E); }
                    GRID_SYNC();
                    if (EN_MIX && EN_DFT && PH(8)) phase_fold(p, S, lgS, B, lds);
                    if (EN_MIX && EN_ATT && PH(4)) phase_qkrope(p, l, S, lgS);
                    for (int rep = 0; rep < REP_PREP; ++rep) { if (EN_MIX && EN_DN && PH(5)) phase_dnprep(p, l, S, lgS, B, lds); }
                    GRID_SYNC();
                    for (int rep = 0; rep < REP_SCAN; ++rep) { if (EN_MIX && EN_DN && PH(6)) phase_dnscan(p, S, lgS, B); }
                    __syncthreads();
                    for (int rep = 0; rep < REP_ATT; ++rep) { if (EN_MIX && EN_ATT && PH(7)) phase_attn(p, S, lgS, B, (int*)(p.ws + WS_CNT) + (pass * 2 + l) * 64, lds); __syncthreads(); }
                    if (EN_MIX && EN_DFT && PH(8)) { KW_PTRS pg8::Gemm g{DFT, (const bf16_t*)(BIG + BG_FT), S, S, 2 * S}; pg8::StaticOrder so; so.init(S >> 8, B, G, cid);
                      pg8::EpiBf16<2> E{YC, 1024, nullptr, rsqrtf((float)S * 64.0f), S};
                      pg8::gemm_phase(lds, g, so, pg8::AddrStd{}, E); }
                    GRID_SYNC();
                    if (EN_MIX && EN_DN && PH(9)) phase_dncombine(p, l);
                    if (EN_CROSS && PH(11)) { KW_PTRS pg8::Gemm g{(const bf16_t*)(ws + WS_MEMB), W + W_KV, 1024, 1024, 1024}; pg8::StaticOrder so; so.init(B, 8, G, cid);
                      pg8::EpiBf16<0> E{(bf16_t*)(BIG + BG_KV), 2048, mssq, 1.0f, S};
                      pg8::gemm_phase(lds, g, so, pg8::AddrStd{}, E); }
                    GRID_SYNC();
                    if (EN_MIX && PH(10)) { KW_PTRS pg8::Gemm g{YC, W + W_OUT, 1024, 1024, 1024}; pg8::StaticOrder so; so.init(256, 4, G, cid, 1);
                      pg8::EpiRes E{X, X, X1, ssq, 1.0f};
                      pg8::gemm_phase(lds, g, so, pg8::AddrStd{}, E); }
                    if (EN_CROSS && PH(12)) { KW_PTRS pg8::Gemm g{(const bf16_t*)(BIG + BG_KV), W + W_QB, 256, 2048, 1024}; pg8::StaticOrder so; so.init(B * 4, 4, G, cid);
                      pg8::EpiBf16<0> E{(bf16_t*)(BIG + BG_WKT), 1024, nullptr, 1.0f, S};
                      pg8::gemm_phase(lds, g, so, pg8::AddrFoldK{}, E); }
                    if (EN_CROSS && PH(13)) { KW_PTRS pg8::Gemm g{W + W_OT, (const bf16_t*)(BIG + BG_KV), 256, 1024, 2048}; pg8::StaticOrder so; so.init(4, B * 4, G, cid);
                      pg8::EpiBf16<1> E{(bf16_t*)(BIG + BG_VWT), 1024, nullptr, 1.0f, S};
                      pg8::gemm_phase(lds, g, so, pg8::AddrFoldV{}, E); }
                    GRID_SYNC();
                    if (EN_CROSS && PH(14)) { KW_PTRS pg8::Gemm g{X1, (const bf16_t*)(BIG + BG_WKT), 1024, 1024, 1024}; pg8::StaticOrder so; so.init(256, 4, G, cid);
                      pg8::EpiSoftmax E{(bf16_t*)(BIG + BG_P), ssq};
                      pg8::gemm_phase(lds, g, so, pg8::AddrBatchB{lgS - 8}, E); }
                    GRID_SYNC();
                    if (EN_CROSS && PH(15)) { KW_PTRS pg8::Gemm g{(const bf16_t*)(BIG + BG_P), (const bf16_t*)(BIG + BG_VWT), 1024, 1024, 1024}; pg8::StaticOrder so; so.init(256, 4, G, cid, 1);
                      pg8::EpiRes E{X, X, X1, ssq, 1.0f};
                      pg8::gemm_phase(lds, g, so, pg8::AddrBatchB{lgS - 8}, E); }
                    GRID_SYNC();
                }
                for (int rep = 0; rep < REP_GU; ++rep) if (EN_FFN && PH(16)) { KW_PTRS pg8::Gemm g{X1, W + (f ? W_GU2 : W_GU1), 1024, 1024, 1024}; pg8::StaticOrder so; so.init(256, 22, G, cid);
                  pg8::EpiSwiglu E{(bf16_t*)BIG, ssq};
                  pg8::gemm_phase(lds, g, so, pg8::AddrStd{}, E); }
                GRID_SYNC();
                if (EN_FFN && PH(17)) { KW_PTRS pg8::Gemm g{(const bf16_t*)BIG, W + (f ? W_D2 : W_D1), 2816, 2816, 2816}; pg8::StaticOrder so; so.init(256, 4, G, cid, 1);
                  pg8::EpiRes E{(l == 0 && f == 0) ? p.in[grp] : (const float*)X, X, (l == 1 && f == 1) ? (bf16_t*)nullptr : X1, ssq, 0.5f};
                  pg8::gemm_phase(lds, g, so, pg8::AddrStd{}, E); }
                GRID_SYNC();
            }
        }
        if (PH(18)) phase_final(p, X);
        GRID_SYNC();
    }
}

extern "C" void kernel_launch(void* const* d_in, const int* in_sizes, int n_in, void* d_out, int out_size, void* d_ws, size_t ws_size, hipStream_t stream) {
    static int grid = 0;
    if (grid == 0) {
        if (n_in != 26 || ws_size < WS_END) { fprintf(stderr, "kernel_launch: unexpected n_in %d / ws_size %zu\n", n_in, ws_size); grid = -1; return; }
        int dev = 0, cus = 0, per_cu = 0;
        hipGetDevice(&dev); hipDeviceGetAttribute(&cus, hipDeviceAttributeMultiprocessorCount, dev);
        hipFuncSetAttribute((const void*)mega_fwd, hipFuncAttributeMaxDynamicSharedMemorySize, LDS_BYTES);
        if (hipOccupancyMaxActiveBlocksPerMultiprocessor(&per_cu, (const void*)mega_fwd, 512, LDS_BYTES) != hipSuccess || per_cu < 1) per_cu = 1;
        (void)hipGetLastError();
        grid = cus * per_cu;
    }
    if (grid < 0) return;
    hipMemsetAsync((char*)d_ws + WS_CNT, 0, 32768, stream);
    Params p{};
    for (int i = 0; i < 26; ++i) p.in[i] = (const float*)d_in[i];
    p.out = (float*)d_out; p.ws = (unsigned char*)d_ws;
    void* args[] = {&p};
    hipError_t e = hipLaunchCooperativeKernel((const void*)mega_fwd, dim3(grid), dim3(512), args, LDS_BYTES, stream);
    if (e != hipSuccess) fprintf(stderr, "cooperative launch failed: %s (grid %d)\n", hipGetErrorString(e), grid);
}
```
